# Optimizing an MI355X kernel written in HIP

```python
import math
import jax, jax.numpy as jnp
from jax import lax
import numpy as np

D_MODEL = 2048
BATCH = 2
SEQ = 16384
DEPTH = 1

D_MIX = D_MODEL
HEAD_DIM = 128
N_Q_HEADS = 8
N_KV_HEADS = 2
GROUP = N_Q_HEADS // N_KV_HEADS
ATTN_W = N_Q_HEADS * HEAD_DIM
LRU_W = D_MIX - ATTN_W
LRU_BLOCKS = 8
LRU_BW = LRU_W // LRU_BLOCKS
LRU_C = 8.0
CONV_W = 4
CONV_LEFT = 2
D_FF = 5632
PLE_DIM = 256
GRID_W = 64
ROPE_THETA = 10000.0
AXIS_DIM = HEAD_DIM // 2
Q_BLOCK = 128
EPS = 1e-6
IN_COLS = ATTN_W + 2 * N_KV_HEADS * HEAD_DIM + 2 * LRU_W

kernel_name = "hymba_style_bidir_attn_rglru_macaron_layer"


def rms_norm(x, g):
    xf = x.astype(jnp.float32)
    y = xf * lax.rsqrt(jnp.mean(xf * xf, axis=-1, keepdims=True) + EPS)
    return (y * g.astype(jnp.float32)).astype(x.dtype)


def swiglu(h, w1, w3, w2):
    return (jax.nn.silu(h @ w1) * (h @ w3)) @ w2


def axial_rope_tables(seq_len, dtype):
    rows = seq_len // GRID_W
    r = jnp.repeat(jnp.arange(rows, dtype=jnp.float32), GRID_W)
    c = jnp.tile(jnp.arange(GRID_W, dtype=jnp.float32), rows)
    inv = ROPE_THETA ** (-jnp.arange(0, AXIS_DIM, 2, dtype=jnp.float32) / AXIS_DIM)
    ang = jnp.concatenate([r[:, None] * inv, c[:, None] * inv], axis=-1)
    return jnp.cos(ang).astype(dtype), jnp.sin(ang).astype(dtype)


def apply_rope(x, cos, sin):
    x1 = x[..., 0::2]
    x2 = x[..., 1::2]
    c = cos[None, :, None, :]
    s = sin[None, :, None, :]
    out = jnp.stack([x1 * c - x2 * s, x1 * s + x2 * c], axis=-1)
    return out.reshape(x.shape)


def bidir_gqa(q, k, v):
    b, s = q.shape[0], q.shape[1]
    nb = s // Q_BLOCK
    scale = 1.0 / math.sqrt(HEAD_DIM)
    qb = q.reshape(b, nb, Q_BLOCK, N_KV_HEADS, GROUP, HEAD_DIM).transpose(1, 0, 2, 3, 4, 5)

    def one_block(qblk):
        sc = jnp.einsum('bqkgd,bskd->bkgqs', qblk, k).astype(jnp.float32) * scale
        pr = jax.nn.softmax(sc, axis=-1).astype(v.dtype)
        return jnp.einsum('bkgqs,bskd->bqkgd', pr, v)

    o = lax.map(one_block, qb)
    return o.transpose(1, 0, 2, 3, 4, 5).reshape(b, s, ATTN_W)


def centred_dw_conv(u, w, bias):
    s = u.shape[1]
    up = jnp.pad(u, ((0, 0), (CONV_LEFT, CONV_W - 1 - CONV_LEFT), (0, 0)))
    out = bias
    for j in range(CONV_W):
        out = out + up[:, j:j + s] * w[j]
    return out


def _lin_combine(e1, e2):
    a1, b1 = e1
    a2, b2 = e2
    return a1 * a2, a2 * b1 + b2


def rglru(u, w_a, b_a, w_i, b_i, lam, reverse):
    b, s, _ = u.shape
    ub = u.reshape(b, s, LRU_BLOCKS, LRU_BW)
    r = jax.nn.sigmoid((jnp.einsum('bshi,hij->bshj', ub, w_a) + b_a).astype(jnp.float32)).reshape(b, s, LRU_W)
    i = jax.nn.sigmoid((jnp.einsum('bshi,hij->bshj', ub, w_i) + b_i).astype(jnp.float32)).reshape(b, s, LRU_W)
    log_a = -LRU_C * jax.nn.softplus(-lam.astype(jnp.float32)) * r
    a = jnp.exp(log_a)
    mult = jnp.sqrt(-jnp.expm1(2.0 * log_a))
    bx = mult * i * u.astype(jnp.float32)
    _, h = lax.associative_scan(_lin_combine, (a, bx), axis=1, reverse=reverse)
    return h.astype(u.dtype)


def setup_inputs(seed: int = 0) -> dict:
    key = jax.random.key(seed)
    ks = jax.random.split(key, 32)
    f32 = jnp.float32

    def w(k, shape, fan_in, gain=1.0):
        return jax.random.normal(k, shape, f32) * (gain * fan_in ** -0.5)

    def gain(k, shape):
        return jnp.ones(shape, f32) + 0.01 * jax.random.normal(k, shape, f32)

    a0 = jax.random.uniform(ks[20], (DEPTH, 2, LRU_W), f32, 0.9, 0.999)
    sg = a0 ** (1.0 / LRU_C)
    lam = jnp.log(sg) - jnp.log1p(-sg)

    return {
        "x": jax.random.normal(ks[0], (BATCH, SEQ, D_MODEL), f32),
        "p": jax.random.normal(ks[1], (DEPTH, BATCH, SEQ, PLE_DIM), f32),
        "norm_ffn1": gain(ks[2], (DEPTH, D_MODEL)),
        "w1_ffn1": w(ks[3], (DEPTH, D_MODEL, D_FF), D_MODEL),
        "w3_ffn1": w(ks[4], (DEPTH, D_MODEL, D_FF), D_MODEL),
        "w2_ffn1": w(ks[5], (DEPTH, D_FF, D_MODEL), D_FF),
        "norm_mix": gain(ks[6], (DEPTH, D_MODEL)),
        "w_in": w(ks[7], (DEPTH, D_MODEL, IN_COLS), D_MODEL),
        "q_norm": gain(ks[8], (DEPTH, HEAD_DIM)),
        "k_norm": gain(ks[9], (DEPTH, HEAD_DIM)),
        "conv_w": w(ks[10], (DEPTH, CONV_W, LRU_W), CONV_W),
        "conv_b": 0.01 * jax.random.normal(ks[11], (DEPTH, LRU_W), f32),
        "lru_wa": w(ks[12], (DEPTH, 2, LRU_BLOCKS, LRU_BW, LRU_BW), LRU_BW),
        "lru_ba": 0.01 * jax.random.normal(ks[13], (DEPTH, 2, LRU_BLOCKS, LRU_BW), f32),
        "lru_wi": w(ks[14], (DEPTH, 2, LRU_BLOCKS, LRU_BW, LRU_BW), LRU_BW),
        "lru_bi": 0.01 * jax.random.normal(ks[15], (DEPTH, 2, LRU_BLOCKS, LRU_BW), f32),
        "lru_lambda": lam,
        "w_out": w(ks[16], (DEPTH, D_MIX, D_MODEL), D_MIX),
        "norm_ffn2": gain(ks[17], (DEPTH, D_MODEL)),
        "w1_ffn2": w(ks[18], (DEPTH, D_MODEL, D_FF), D_MODEL),
        "w3_ffn2": w(ks[19], (DEPTH, D_MODEL, D_FF), D_MODEL),
        "w2_ffn2": w(ks[21], (DEPTH, D_FF, D_MODEL), D_FF),
        "norm_ple": gain(ks[22], (DEPTH, D_MODEL)),
        "w_ple_gate": w(ks[23], (DEPTH, D_MODEL, D_MODEL), D_MODEL),
        "w_ple_proj": w(ks[24], (DEPTH, PLE_DIM, D_MODEL), PLE_DIM),
        "norm_final": gain(ks[25], (D_MODEL,)),
    }


def reference(x, p, norm_ffn1, w1_ffn1, w3_ffn1, w2_ffn1, norm_mix, w_in, q_norm, k_norm,
              conv_w, conv_b, lru_wa, lru_ba, lru_wi, lru_bi, lru_lambda, w_out,
              norm_ffn2, w1_ffn2, w3_ffn2, w2_ffn2, norm_ple, w_ple_gate, w_ple_proj,
              norm_final):
    b, s, _ = x.shape
    cos, sin = axial_rope_tables(s, x.dtype)
    kv_w = N_KV_HEADS * HEAD_DIM
    for l in range(DEPTH):
        x = x + 0.5 * swiglu(rms_norm(x, norm_ffn1[l]), w1_ffn1[l], w3_ffn1[l], w2_ffn1[l])

        h = rms_norm(x, norm_mix[l])
        proj = h @ w_in[l]
        q = proj[..., :ATTN_W].reshape(b, s, N_Q_HEADS, HEAD_DIM)
        k = proj[..., ATTN_W:ATTN_W + kv_w].reshape(b, s, N_KV_HEADS, HEAD_DIM)
        v = proj[..., ATTN_W + kv_w:ATTN_W + 2 * kv_w].reshape(b, s, N_KV_HEADS, HEAD_DIM)
        u = proj[..., ATTN_W + 2 * kv_w:ATTN_W + 2 * kv_w + LRU_W]
        y = proj[..., ATTN_W + 2 * kv_w + LRU_W:]

        q = apply_rope(rms_norm(q, q_norm[l]), cos, sin)
        k = apply_rope(rms_norm(k, k_norm[l]), cos, sin)
        attn_out = bidir_gqa(q, k, v)

        uc = centred_dw_conv(u, conv_w[l], conv_b[l])
        h_f = rglru(uc, lru_wa[l, 0], lru_ba[l, 0], lru_wi[l, 0], lru_bi[l, 0], lru_lambda[l, 0], False)
        h_b = rglru(uc, lru_wa[l, 1], lru_ba[l, 1], lru_wi[l, 1], lru_bi[l, 1], lru_lambda[l, 1], True)
        lru_out = (h_f + h_b) * jax.nn.gelu(y)

        mixed = jnp.concatenate([attn_out, lru_out], axis=-1)
        x = x + mixed @ w_out[l]

        x = x + 0.5 * swiglu(rms_norm(x, norm_ffn2[l]), w1_ffn2[l], w3_ffn2[l], w2_ffn2[l])

        gate = jax.nn.sigmoid(rms_norm(x, norm_ple[l]) @ w_ple_gate[l])
        x = x + gate * (p[l] @ w_ple_proj[l])
    return rms_norm(x, norm_final)
```

```cpp
#include <hip/hip_runtime.h>
#include <hip/hip_cooperative_groups.h>
#include <cstdio>
#include <cstdint>
namespace cg = cooperative_groups;

#ifndef MK_ONE_LAUNCH
#define MK_ONE_LAUNCH 1
#endif

#define LAS __attribute__((address_space(3)))
typedef unsigned short bf16_t;
typedef short bf16x8 __attribute__((ext_vector_type(8)));
typedef short s16x4 __attribute__((ext_vector_type(4)));
typedef float f32x4 __attribute__((ext_vector_type(4)));
typedef float f32x2 __attribute__((ext_vector_type(2)));
typedef float f32x16 __attribute__((ext_vector_type(16)));
typedef unsigned u32x4 __attribute__((ext_vector_type(4)));
typedef unsigned u32x2 __attribute__((ext_vector_type(2)));

constexpr int BATCH = 2, SEQ = 16384, DM = 2048, T = BATCH * SEQ, DFF = 5632, INC = 3584, PLED = 256;
constexpr int LRUW = 1024, QKVW = 1536, NCH = 128, CL = 128;
constexpr float EPS = 1e-6f;

constexpr size_t MiB = 1u << 20;
constexpr size_t WS_SS = 0;
constexpr size_t WS_ROPE = 1 * MiB, WS_C8 = 1 * MiB + 128 * 1024;
constexpr size_t WS_BAR = 1 * MiB + 512 * 1024, BAR_BYTES = 16384;
constexpr size_t WS_AGGA = 2 * MiB, WS_AGGH = 4 * MiB;
constexpr size_t WS_W13_1 = 8 * MiB, WS_W2_1 = 52 * MiB, WS_W13_2 = 74 * MiB, WS_W2_2 = 118 * MiB;
constexpr size_t WS_WIN = 140 * MiB, WS_WOUT = 154 * MiB, WS_WG = 162 * MiB, WS_WP = 170 * MiB, WS_WL = 171 * MiB;
constexpr size_t WS_PB = 172 * MiB;
constexpr size_t WS_XB = 188 * MiB;
constexpr size_t WS_X = 316 * MiB;
constexpr size_t WS_H = 572 * MiB;
constexpr size_t WS_RA = WS_H, WS_BX = WS_H + 128 * MiB, WS_QKV = WS_H + 256 * MiB;
constexpr size_t WS_END = 924 * MiB;
constexpr size_t DO_U = 0, DO_UC = 64 * MiB, DO_GY = 128 * MiB, DO_MIX = 0, DO_PP = 128 * MiB;
constexpr size_t DO_Q8 = 192 * MiB, DO_K8 = 224 * MiB, DO_V8 = 232 * MiB;

__device__ __forceinline__ unsigned cvt_pk_bf16(float lo, float hi) { unsigned r; asm volatile("v_cvt_pk_bf16_f32 %0, %1, %2" : "=v"(r) : "v"(lo), "v"(hi)); return r; }
__device__ __forceinline__ float bf_lo(unsigned w) { return __uint_as_float(w << 16); }
__device__ __forceinline__ float bf_hi(unsigned w) { return __uint_as_float(w & 0xffff0000u); }
__device__ __forceinline__ float sigmoidf_(float x) { return __builtin_amdgcn_rcpf(1.0f + __expf(-x)); }
__device__ __forceinline__ float wave_sum(float v) {
#pragma unroll
    for (int o = 1; o < 64; o <<= 1) v += __shfl_xor(v, o);
    return v;
}

namespace pg8 {
constexpr int BM = 256, BK = 64, HALF = 128, HTB = HALF * BK * 2, STAGE_BYTES = 8 * HTB, NXCD = 8, WGM = 8;
__host__ __device__ __forceinline__ int lds_byte(int r, int c) { const int st = (r >> 4) * 2 + (c >> 5), rr = r & 15, cc = c & 31, ob = rr * 64 + cc * 2; return st * 1024 + (ob ^ (((ob >> 9) & 1) << 5)); }
__host__ __device__ __forceinline__ void stage_rc(int b, int& R, int& C) { const int st = b / 1024, sb = b % 1024, swz = sb ^ (((sb >> 9) & 1) << 5); R = (st >> 1) * 16 + swz / 64; C = (st & 1) * 32 + (swz % 64) / 2; }
__host__ __device__ __forceinline__ int perm32(int rho) { const int n = rho >> 4, i = rho & 15; return 8 * (i >> 2) + 4 * n + (i & 3); }

struct Unit { int pm, pn; };
struct Gemm { const bf16_t* A; const bf16_t* Bt; int M, N, K, lda, ldb, amask, astride; };

struct StaticOrder {
    int nM, nN, nwg, G, c;
    __device__ void init(int M, int N, int G_, int c_) { nM = M / BM; nN = N / BM; nwg = nM * nN; G = G_; c = c_; }
    __device__ bool next(int i, Unit& u) const {
        const long L = (long)i * G + c; if (L >= nwg) return false;
        int wgid = (int)L; { const int q = nwg / NXCD, r = nwg % NXCD, xcd = wgid % NXCD, off = wgid / NXCD; wgid = (xcd < r ? xcd * (q + 1) : r * (q + 1) + (xcd - r) * q) + off; }
        const int nig = WGM * nN, gid = wgid / nig, fm = gid * WGM, gsz = (nM - fm) < WGM ? (nM - fm) : WGM;
        u.pm = fm + ((wgid % nig) % gsz); u.pn = (wgid % nig) / gsz; return true;
    }
};

enum { M_SWIGLU = 0, M_RESID = 1, M_WIN = 2, M_GATES = 3, M_PLAIN = 4, M_PLE = 5 };
template <int mode> struct Epi {
    float alpha;
    const float* base; float* Xo; bf16_t* XBo; float* ss_out; const float* ss_in;
    bf16_t* O0; bf16_t* O1; bf16_t* O2; const bf16_t* aux;
    const float* ba; const float* bi; const float* lam;
    __device__ __forceinline__ float rs_of(int row) const { return __builtin_amdgcn_rsqf(ss_in[row] * (1.0f / DM) + EPS); }
    __device__ __forceinline__ void operator()(const f32x4 (&acc)[2][2][4][2], const Unit& u, int wr, int wc, int fr, int fq) const {
        const int row0 = u.pm * BM + wr * 64 + fr;
        const int cw = wc * 32 + 8 * fq;
        if constexpr (mode == M_SWIGLU) {
#pragma unroll
            for (int ai = 0; ai < 2; ++ai)
#pragma unroll
                for (int m = 0; m < 4; ++m) {
                    const int row = row0 + ai * HALF + m * 16;
                    const float s = ss_in ? rs_of(row) : 1.0f;
                    u32x4 w; float v[8];
#pragma unroll
                    for (int n = 0; n < 2; ++n)
#pragma unroll
                        for (int e = 0; e < 4; ++e) { const float a = acc[ai][0][m][n][e] * s, b = acc[ai][1][m][n][e] * s; v[4 * n + e] = a * b * sigmoidf_(a); }
                    w.x = cvt_pk_bf16(v[0], v[1]); w.y = cvt_pk_bf16(v[2], v[3]); w.z = cvt_pk_bf16(v[4], v[5]); w.w = cvt_pk_bf16(v[6], v[7]);
                    *(u32x4*)(O0 + (size_t)row * DFF + u.pn * HALF + cw) = w;
                }
        } else if constexpr (mode == M_RESID || mode == M_PLE) {
            f32x4 cx[2][2], nx[2][2]; u32x4 cp_[2], np_[2];
#define RP_LOAD(dx_, dp_, it_) do { const int row_ = row0 + ((it_) >> 2) * HALF + ((it_) & 3) * 16; _Pragma("unroll") for (int bj = 0; bj < 2; ++bj) { const size_t off_ = (size_t)row_ * DM + u.pn * BM + bj * HALF + cw; \
                dx_[bj][0] = *(const f32x4*)(base + off_); dx_[bj][1] = *(const f32x4*)(base + off_ + 4); if (mode == M_PLE) dp_[bj] = *(const u32x4*)(aux + off_); } } while (0)
            RP_LOAD(cx, cp_, 0);
#pragma unroll
            for (int it = 0; it < 8; ++it) {
                const int ai = it >> 2, m = it & 3;
                const int row = row0 + ai * HALF + m * 16;
                if (it + 1 < 8) RP_LOAD(nx, np_, it + 1);
                const float s = (mode == M_PLE) ? rs_of(row) : 1.0f;
                float sq = 0.f;
#pragma unroll
                for (int bj = 0; bj < 2; ++bj) {
                    const size_t off = (size_t)row * DM + u.pn * BM + bj * HALF + cw;
                    f32x4 x0 = cx[bj][0], x1 = cx[bj][1];
                    if (mode == M_PLE) {
                        const u32x4 pw = cp_[bj];
                        const f32x4 a0 = acc[ai][bj][m][0] * s, a1 = acc[ai][bj][m][1] * s;
                        x0[0] += sigmoidf_(a0[0]) * bf_lo(pw.x); x0[1] += sigmoidf_(a0[1]) * bf_hi(pw.x); x0[2] += sigmoidf_(a0[2]) * bf_lo(pw.y); x0[3] += sigmoidf_(a0[3]) * bf_hi(pw.y);
                        x1[0] += sigmoidf_(a1[0]) * bf_lo(pw.z); x1[1] += sigmoidf_(a1[1]) * bf_hi(pw.z); x1[2] += sigmoidf_(a1[2]) * bf_lo(pw.w); x1[3] += sigmoidf_(a1[3]) * bf_hi(pw.w);
                    } else {
                        x0 += acc[ai][bj][m][0] * alpha; x1 += acc[ai][bj][m][1] * alpha;
                    }
                    *(f32x4*)(Xo + off) = x0; *(f32x4*)(Xo + off + 4) = x1;
                    if (mode == M_RESID) { u32x4 w; w.x = cvt_pk_bf16(x0[0], x0[1]); w.y = cvt_pk_bf16(x0[2], x0[3]); w.z = cvt_pk_bf16(x1[0], x1[1]); w.w = cvt_pk_bf16(x1[2], x1[3]); *(u32x4*)(XBo + off) = w; }
                    sq += (x0[0] * x0[0] + x0[1] * x0[1]) + (x0[2] * x0[2] + x0[3] * x0[3]) + (x1[0] * x1[0] + x1[1] * x1[1]) + (x1[2] * x1[2] + x1[3] * x1[3]);
                }
                sq += __shfl_xor(sq, 16); sq += __shfl_xor(sq, 32);
                if (fq == 0) __hip_atomic_fetch_add(ss_out + row, sq, __ATOMIC_RELAXED, __HIP_MEMORY_SCOPE_AGENT);
#pragma unroll
                for (int bj = 0; bj < 2; ++bj) { cx[bj][0] = nx[bj][0]; cx[bj][1] = nx[bj][1]; cp_[bj] = np_[bj]; }
            }
#undef RP_LOAD
        } else if constexpr (mode == M_WIN) {
            const int pn = u.pn;
            bf16_t* dst; int ld, c0;
            if (pn < 6) { dst = O0; ld = QKVW; c0 = pn * BM; } else if (pn < 10) { dst = O1; ld = LRUW; c0 = (pn - 6) * BM; } else { dst = O2; ld = LRUW; c0 = (pn - 10) * BM; }
            const bool act = pn >= 10;
#pragma unroll
            for (int ai = 0; ai < 2; ++ai)
#pragma unroll
                for (int m = 0; m < 4; ++m) {
                    const int row = row0 + ai * HALF + m * 16;
                    const float s = rs_of(row);
#pragma unroll
                    for (int bj = 0; bj < 2; ++bj) {
                        float v[8];
#pragma unroll
                        for (int n = 0; n < 2; ++n)
#pragma unroll
                            for (int e = 0; e < 4; ++e) { float x = acc[ai][bj][m][n][e] * s;
                                if (act) { const float z = 1.5957691216f * (x + 0.044715f * x * x * x); x = x * sigmoidf_(z); }
                                v[4 * n + e] = x; }
                        u32x4 w; w.x = cvt_pk_bf16(v[0], v[1]); w.y = cvt_pk_bf16(v[2], v[3]); w.z = cvt_pk_bf16(v[4], v[5]); w.w = cvt_pk_bf16(v[6], v[7]);
                        *(u32x4*)(dst + (size_t)row * ld + c0 + bj * HALF + cw) = w;
                    }
                }
        } else if constexpr (mode == M_GATES) {
            const int dir = u.pn >> 3, h = u.pn & 7;
            const int chb = h * HALF + cw;
            f32x4 vba[2], vbi[2], c8[2];
#pragma unroll
            for (int n = 0; n < 2; ++n) { vba[n] = *(const f32x4*)(ba + dir * LRUW + chb + 4 * n); vbi[n] = *(const f32x4*)(bi + dir * LRUW + chb + 4 * n); c8[n] = *(const f32x4*)(lam + dir * LRUW + chb + 4 * n); }
            u32x4 uwv[2][4];
#pragma unroll
            for (int ai = 0; ai < 2; ++ai)
#pragma unroll
                for (int m = 0; m < 4; ++m) uwv[ai][m] = *(const u32x4*)(aux + (size_t)(row0 + ai * HALF + m * 16) * LRUW + chb);
#pragma unroll
            for (int ai = 0; ai < 2; ++ai)
#pragma unroll
                for (int m = 0; m < 4; ++m) {
                    const int row = row0 + ai * HALF + m * 16;
                    const u32x4 uw = uwv[ai][m];
                    u32x4 wr_, wb_;
#pragma unroll
                    for (int n = 0; n < 2; ++n) {
                        float rr[4], bx[4];
#pragma unroll
                        for (int e = 0; e < 4; ++e) {
                            const unsigned uword = (n == 0) ? (e < 2 ? uw.x : uw.y) : (e < 2 ? uw.z : uw.w);
                            const float ucv = (e & 1) ? bf_hi(uword) : bf_lo(uword);
                            const float r = sigmoidf_(acc[ai][0][m][n][e] + vba[n][e]), ig = sigmoidf_(acc[ai][1][m][n][e] + vbi[n][e]);
                            const float a2 = __builtin_amdgcn_exp2f(2.0f * c8[n][e] * r);
                            rr[e] = r; bx[e] = __builtin_amdgcn_sqrtf(fmaxf(1.0f - a2, 0.f)) * ig * ucv; }
                        if (n == 0) { wr_.x = cvt_pk_bf16(rr[0], rr[1]); wr_.y = cvt_pk_bf16(rr[2], rr[3]); wb_.x = cvt_pk_bf16(bx[0], bx[1]); wb_.y = cvt_pk_bf16(bx[2], bx[3]); }
                        else { wr_.z = cvt_pk_bf16(rr[0], rr[1]); wr_.w = cvt_pk_bf16(rr[2], rr[3]); wb_.z = cvt_pk_bf16(bx[0], bx[1]); wb_.w = cvt_pk_bf16(bx[2], bx[3]); }
                    }
                    *(u32x4*)(O0 + ((size_t)dir * T + row) * LRUW + chb) = wr_;
                    *(u32x4*)(O1 + ((size_t)dir * T + row) * LRUW + chb) = wb_;
                }
        } else {
#pragma unroll
            for (int ai = 0; ai < 2; ++ai)
#pragma unroll
                for (int m = 0; m < 4; ++m) {
                    const int row = row0 + ai * HALF + m * 16;
#pragma unroll
                    for (int bj = 0; bj < 2; ++bj) {
                        const f32x4 v0 = acc[ai][bj][m][0], v1 = acc[ai][bj][m][1];
                        u32x4 w; w.x = cvt_pk_bf16(v0[0], v0[1]); w.y = cvt_pk_bf16(v0[2], v0[3]); w.z = cvt_pk_bf16(v1[0], v1[1]); w.w = cvt_pk_bf16(v1[2], v1[3]);
                        *(u32x4*)(O0 + (size_t)row * DM + u.pn * BM + bj * HALF + cw) = w;
                    }
                }
        }
    }
};

template <class Epi> __device__ __forceinline__ void gemm_phase(LAS unsigned char* lds, const Gemm g, const StaticOrder& S, const Epi& E, const int tid) {
    const int wid = __builtin_amdgcn_readfirstlane(tid >> 6), lane = tid & 63, wr = wid >> 2, wc = wid & 3, fr = lane & 15, fq = lane >> 4;
    int K = g.K; asm volatile("" : "+s"(K)); const int nt = K / BK;
    unsigned voffA[2], voffB[2];
#pragma unroll
    for (int i = 0; i < 2; ++i) { int R, C; stage_rc(tid * 16 + i * 8192, R, C); const int Rb = (R & ~31) + perm32(R & 31);
        voffA[i] = (unsigned)(R * g.lda + C) * 2u; voffB[i] = (unsigned)(Rb * g.ldb + C) * 2u; }
    const size_t kstep = (size_t)(BK * 2);
    const size_t hstepA = (size_t)HALF * g.lda * 2, hstepB = (size_t)HALF * g.ldb * 2;
    const size_t tstepA = 2 * hstepA, tstepB = 2 * hstepB;
    const unsigned ldsw = (unsigned)wid * 1024u;
    const int aoff = lds_byte(wr * 64 + fr, fq * 8), boff = lds_byte(wc * 32 + fr, fq * 8);
#define PG8_SA(b, h) (((b) * 2 + (h)) * HTB)
#define PG8_SB(b, h) ((4 + (b) * 2 + (h)) * HTB)
#define PG8_STAGE(bufoff, gbase, voff) do { _Pragma("unroll") for (int _i = 0; _i < 2; ++_i) \
        __builtin_amdgcn_global_load_lds((const unsigned*)((const char*)(gbase) + (voff)[_i]), (LAS unsigned*)(lds + (bufoff) + ldsw + _i * 8192), 16, 0, 0); } while (0)
#define PG8_LDA(dst, b, h) do { _Pragma("unroll") for (int m = 0; m < 4; ++m) _Pragma("unroll") for (int k = 0; k < 2; ++k) dst[m][k] = *(const LAS bf16x8*)(lds + PG8_SA(b, h) + aoff + m * 2048 + k * 1024); } while (0)
#define PG8_LDB(dst, b, h) do { _Pragma("unroll") for (int n = 0; n < 2; ++n) _Pragma("unroll") for (int k = 0; k < 2; ++k) dst[n][k] = *(const LAS bf16x8*)(lds + PG8_SB(b, h) + boff + n * 2048 + k * 1024); } while (0)
#define PG8_MMA(ai, bj, At, Bt) do { __builtin_amdgcn_s_setprio(1); _Pragma("unroll") for (int m = 0; m < 4; ++m) _Pragma("unroll") for (int n = 0; n < 2; ++n) _Pragma("unroll") for (int k = 0; k < 2; ++k) \
        acc[ai][bj][m][n] = __builtin_amdgcn_mfma_f32_16x16x32_bf16(Bt[n][k], At[m][k], acc[ai][bj][m][n], 0, 0, 0); __builtin_amdgcn_s_setprio(0); } while (0)
#define PG8_WAIT_V(n) asm volatile("s_waitcnt vmcnt(" #n ")" ::: "memory")
#define PG8_WAIT_L(n) asm volatile("s_waitcnt lgkmcnt(" #n ")" ::: "memory")
#define PG8_BAR __builtin_amdgcn_s_barrier()
#define PG8_SCHED __builtin_amdgcn_sched_barrier(0)
    Unit cur, nxt; int ui = 0;
    if (!S.next(0, cur)) return;
    f32x4 acc[2][2][4][2];
#pragma unroll
    for (int a = 0; a < 2; ++a)
#pragma unroll
        for (int b = 0; b < 2; ++b)
#pragma unroll
            for (int m = 0; m < 4; ++m)
#pragma unroll
                for (int n = 0; n < 2; ++n) acc[a][b][m][n] = (f32x4){0.f, 0.f, 0.f, 0.f};
    bf16x8 At[4][2], B0[2][2], B1[2][2];
    const char* cA = (const char*)g.A + (size_t)cur.pm * tstepA + (size_t)(cur.pn & g.amask) * g.astride; const char* cB = (const char*)g.Bt + (size_t)cur.pn * tstepB;
    PG8_STAGE(PG8_SB(0, 0), cB, voffB); PG8_STAGE(PG8_SB(0, 1), cB + hstepB, voffB); PG8_STAGE(PG8_SA(0, 0), cA, voffA); PG8_STAGE(PG8_SA(0, 1), cA + hstepA, voffA);
    if (wr == 1) PG8_BAR;
    PG8_WAIT_V(2); PG8_BAR;
    PG8_STAGE(PG8_SB(1, 0), cB + kstep, voffB); PG8_STAGE(PG8_SA(1, 0), cA + kstep, voffA); PG8_STAGE(PG8_SB(1, 1), cB + hstepB + kstep, voffB);
    PG8_WAIT_V(6); PG8_BAR;
    for (;;) {
        const bool has_next = S.next(ui + 1, nxt);
        const char* nA = has_next ? (const char*)g.A + (size_t)nxt.pm * tstepA + (size_t)(nxt.pn & g.amask) * g.astride : cA; const char* nB = has_next ? (const char*)g.Bt + (size_t)nxt.pn * tstepB : cB;
        for (int t = 0; t < nt; t += 2) {
            const bool last = (t == nt - 2);
            const char* a1 = cA + (size_t)(t + 1) * kstep;
            const char* a2 = last ? nA : cA + (size_t)(t + 2) * kstep; const char* b2 = last ? nB : cB + (size_t)(t + 2) * kstep;
            const char* a3 = a2 + kstep; const char* b3 = b2 + kstep;
            PG8_LDB(B0, 0, 0); PG8_LDB(B1, 0, 1); PG8_SCHED; PG8_LDA(At, 0, 0); PG8_STAGE(PG8_SA(1, 1), a1 + hstepA, voffA);
            PG8_WAIT_V(8); PG8_WAIT_L(0); PG8_BAR; PG8_MMA(0, 0, At, B0); PG8_MMA(0, 1, At, B1); PG8_BAR; PG8_SCHED;
            PG8_LDA(At, 0, 1); PG8_STAGE(PG8_SB(0, 0), b2, voffB); PG8_STAGE(PG8_SB(0, 1), b2 + hstepB, voffB); PG8_STAGE(PG8_SA(0, 0), a2, voffA);
            PG8_WAIT_V(8); PG8_WAIT_L(0); PG8_BAR; PG8_MMA(1, 0, At, B0); PG8_MMA(1, 1, At, B1); PG8_BAR; PG8_SCHED;
            PG8_LDB(B0, 1, 0); PG8_LDB(B1, 1, 1); PG8_SCHED; PG8_LDA(At, 1, 0); PG8_STAGE(PG8_SA(0, 1), a2 + hstepA, voffA);
            PG8_WAIT_V(8); PG8_WAIT_L(0); PG8_BAR; PG8_MMA(0, 0, At, B0); PG8_MMA(0, 1, At, B1); PG8_BAR; PG8_SCHED;
            PG8_LDA(At, 1, 1); PG8_STAGE(PG8_SB(1, 0), b3, voffB); PG8_STAGE(PG8_SB(1, 1), b3 + hstepB, voffB); PG8_STAGE(PG8_SA(1, 0), a3, voffA);
            PG8_WAIT_V(8); PG8_WAIT_L(0); PG8_BAR; PG8_MMA(1, 0, At, B0); PG8_MMA(1, 1, At, B1); PG8_BAR; PG8_SCHED;
        }
        if (wr == 0) PG8_BAR;
        E(acc, cur, wr, wc, fr, fq);
        if (!has_next) break;
#pragma unroll
        for (int a = 0; a < 2; ++a)
#pragma unroll
            for (int b = 0; b < 2; ++b)
#pragma unroll
                for (int m = 0; m < 4; ++m)
#pragma unroll
                    for (int n = 0; n < 2; ++n) acc[a][b][m][n] = (f32x4){0.f, 0.f, 0.f, 0.f};
        cur = nxt; cA = nA; cB = nB; ++ui;
        if (wr == 1) PG8_BAR;
    }
    PG8_WAIT_V(0);
    PG8_BAR;
#undef PG8_SA
#undef PG8_SB
#undef PG8_STAGE
#undef PG8_LDA
#undef PG8_LDB
#undef PG8_MMA
#undef PG8_WAIT_V
#undef PG8_WAIT_L
#undef PG8_BAR
#undef PG8_SCHED
}
}

namespace att {
constexpr int D = 128, NW = 8, QBLK = 32, KVBLK = 64;
constexpr float SCALE = 0.088388347648318440f;
constexpr float THR = 8.f;
constexpr int LDQ = QKVW, LDK = QKVW, LDO = DM;
constexpr size_t SHM_V = KVBLK * D * 2, SHM_K = KVBLK * D * 2, SHM_ATTN = 2 * SHM_V + 2 * SHM_K + NW * 64 * 4;
#define KSWZ(row, colB) ((row) * 256 + ((colB) ^ (((row) & 7) << 4)))
#define SBAR() __builtin_amdgcn_sched_barrier(0)
__device__ __forceinline__ int crow(int r, int hi) { return (r & 3) + 8 * (r >> 2) + 4 * hi; }
__device__ __forceinline__ void partialSM(f32x16& p0, f32x16& p1, float& m_reg, float& mn, float& alpha) {
  constexpr float C = SCALE * 1.4426950408889634f;
  float pmax = p0[0]; for (int r = 1; r < 16; ++r) pmax = fmaxf(pmax, p0[r]); for (int r = 0; r < 16; ++r) pmax = fmaxf(pmax, p1[r]);
  { auto rr = __builtin_amdgcn_permlane32_swap(__float_as_uint(pmax), __float_as_uint(pmax), false, false);
    pmax = fmaxf(__uint_as_float(rr[0]), __uint_as_float(rr[1])); }
  if (__builtin_expect(__all(pmax - m_reg <= THR / SCALE), 1)) { mn = m_reg; alpha = 1.f; }
  else { mn = fmaxf(m_reg, pmax); alpha = __builtin_amdgcn_exp2f((m_reg - mn) * C); m_reg = mn; }
  float mnC = -mn * C;
  for (int r = 0; r < 16; ++r) p0[r] = fmaf(p0[r], C, mnC); for (int r = 0; r < 16; ++r) p1[r] = fmaf(p1[r], C, mnC);
  for (int r = 0; r < 16; ++r) p0[r] = __builtin_amdgcn_exp2f(p0[r]);
}
__device__ __forceinline__ void finishSM(f32x16& p0, f32x16& p1, float alpha, float& l_reg, bf16x8& pa0, bf16x8& pa1, bf16x8& pa2, bf16x8& pa3) {
  for (int r = 0; r < 16; ++r) p1[r] = __builtin_amdgcn_exp2f(p1[r]);
  float ps = 0; for (int r = 0; r < 16; ++r) ps += p0[r]; for (int r = 0; r < 16; ++r) ps += p1[r];
  { auto rr = __builtin_amdgcn_permlane32_swap(__float_as_uint(ps), __float_as_uint(ps), false, false);
    ps = __uint_as_float(rr[0]) + __uint_as_float(rr[1]); }
  l_reg = l_reg * alpha + ps;
#define PK4(P, BASE, OUT) do { unsigned a0 = cvt_pk_bf16(P[BASE + 0], P[BASE + 1]), a1 = cvt_pk_bf16(P[BASE + 2], P[BASE + 3]);   \
    unsigned b0 = cvt_pk_bf16(P[BASE + 4], P[BASE + 5]), b1 = cvt_pk_bf16(P[BASE + 6], P[BASE + 7]);                              \
    auto r0 = __builtin_amdgcn_permlane32_swap(a0, b0, false, false); auto r1 = __builtin_amdgcn_permlane32_swap(a1, b1, false, false); \
    u32x4 w = {r0[0], r1[0], r0[1], r1[1]}; OUT = *reinterpret_cast<bf16x8*>(&w); } while (0)
  PK4(p0, 0, pa0); PK4(p0, 8, pa1); PK4(p1, 0, pa2); PK4(p1, 8, pa3);
#undef PK4
}
__device__ __forceinline__ void qkt(f32x16& p0, f32x16& p1, const bf16_t* Ks, const bf16x8* qr, int r32, int hi) {
  p0 = f32x16{}; p1 = f32x16{};
  for (int d0 = 0; d0 < 8; ++d0) { int cb = (d0 * 16 + hi * 8) * 2;
    bf16x8 b0 = *reinterpret_cast<const bf16x8*>((const char*)Ks + KSWZ(r32, cb));
    bf16x8 b1 = *reinterpret_cast<const bf16x8*>((const char*)Ks + KSWZ(32 + r32, cb));
    p0 = __builtin_amdgcn_mfma_f32_32x32x16_bf16(b0, qr[d0], p0, 0, 0, 0);
    p1 = __builtin_amdgcn_mfma_f32_32x32x16_bf16(b1, qr[d0], p1, 0, 0, 0); }
}
__device__ __forceinline__ int v_st(int k, int c) { const int kk = (k & ~0xC) | ((k & 4) << 1) | ((k & 8) >> 1); return ((kk >> 3) * 4 + (c >> 5)) * 512 + ((kk & 7) * 32 + (c & 31)) * 2; }
__device__ __forceinline__ int v_rd_base(int lane) { return ((lane & 3) << 3) | (((lane >> 2) & 3) << 6) | (((lane >> 4) & 1) << 5) | (((lane >> 5) & 1) << 8); }
constexpr int v_rd_off(int d0, int ks, int half) { return d0 * 512 + ks * 4096 + half * 2048; }
template <int OFF> __device__ __forceinline__ s16x4 tr_read(int vb) {
  s16x4 r; asm volatile("ds_read_b64_tr_b16 %0, %1 offset:%2" : "=&v"(r) : "v"(vb), "i"(OFF) : "memory"); return r;
}
template <int D0> __device__ __forceinline__ void pv_one(f32x16& od, int vb, bf16x8 pa0, bf16x8 pa1, bf16x8 pa2, bf16x8 pa3) {
  const s16x4 l0 = tr_read<v_rd_off(D0, 0, 0)>(vb), h0 = tr_read<v_rd_off(D0, 0, 1)>(vb), l1 = tr_read<v_rd_off(D0, 1, 0)>(vb), h1 = tr_read<v_rd_off(D0, 1, 1)>(vb);
  const s16x4 l2 = tr_read<v_rd_off(D0, 2, 0)>(vb), h2 = tr_read<v_rd_off(D0, 2, 1)>(vb), l3 = tr_read<v_rd_off(D0, 3, 0)>(vb), h3 = tr_read<v_rd_off(D0, 3, 1)>(vb);
  asm volatile("s_waitcnt lgkmcnt(0)" ::: "memory"); SBAR();
#define PK(L, H) (bf16x8){L[0], L[1], L[2], L[3], H[0], H[1], H[2], H[3]}
  od = __builtin_amdgcn_mfma_f32_32x32x16_bf16(pa0, PK(l0, h0), od, 0, 0, 0);
  od = __builtin_amdgcn_mfma_f32_32x32x16_bf16(pa1, PK(l1, h1), od, 0, 0, 0);
  od = __builtin_amdgcn_mfma_f32_32x32x16_bf16(pa2, PK(l2, h2), od, 0, 0, 0);
  od = __builtin_amdgcn_mfma_f32_32x32x16_bf16(pa3, PK(l3, h3), od, 0, 0, 0);
#undef PK
}
__device__ __forceinline__ void pv_d0(f32x16* o, int vb, bf16x8 pa0, bf16x8 pa1, bf16x8 pa2, bf16x8 pa3) {
  pv_one<0>(o[0], vb, pa0, pa1, pa2, pa3); pv_one<1>(o[1], vb, pa0, pa1, pa2, pa3); pv_one<2>(o[2], vb, pa0, pa1, pa2, pa3); pv_one<3>(o[3], vb, pa0, pa1, pa2, pa3);
}
__device__ __forceinline__ void glds16(unsigned voff, const void* sbase, unsigned lds_dst) {
  unsigned keep;
  asm volatile("s_mov_b32 %0, m0\n\ts_mov_b32 m0, %3\n\ts_nop 0\n\tglobal_load_lds_dwordx4 %1, %2\n\ts_mov_b32 m0, %0" : "=&s"(keep) : "v"(voff), "s"(sbase), "s"(lds_dst) : "memory");
}
#define WAIT_BAR(N) asm volatile("s_waitcnt vmcnt(" #N ") lgkmcnt(0)\n\ts_barrier" ::: "memory")
constexpr int SLOT = 16384, LK = 0, LV = 3 * SLOT, LWS = 6 * SLOT;
__device__ __forceinline__ void attn_dense_body(const bf16_t* __restrict__ Qb, const bf16_t* __restrict__ Kh, const bf16_t* __restrict__ Vh,
                                                bf16_t* __restrict__ Ob, int seq, char* lds, const int tid) {
  const int wid = __builtin_amdgcn_readfirstlane(tid >> 6), lane = tid & 63, r32 = lane & 31, hi = lane >> 5;
  const unsigned lds0 = (unsigned)(uintptr_t)lds;
  float* ws = (float*)(lds + LWS) + wid * 64; float* li_l = ws; float* al_l = ws + 32;
  float m_reg = -1e30f, l_reg = 0; f32x16 o[4] = {}; bf16x8 qr[8];
  const bf16_t* Qw = Qb + (long)(wid * QBLK + r32) * LDQ + hi * 8;
#pragma unroll
  for (int d0 = 0; d0 < 8; ++d0) qr[d0] = *reinterpret_cast<const bf16x8*>(Qw + d0 * 16);
  unsigned kof[2], vof[2];
#pragma unroll
  for (int i = 0; i < 2; ++i) { const int S = (i * 8 + wid) * 1024 + lane * 16;
    const int krow = S >> 8, kcolB = (S & 255) ^ ((krow & 7) << 4); kof[i] = (unsigned)(krow * (LDK * 2) + kcolB);
    const int sub = S >> 9, kk = (sub >> 2) * 8 + ((S & 511) >> 6), k = (kk & ~0xC) | ((kk & 4) << 1) | ((kk & 8) >> 1), c = (sub & 3) * 32 + ((S & 63) >> 1);
    vof[i] = (unsigned)(k * (LDK * 2) + c * 2); }
  const unsigned kdst = lds0 + LK + wid * 1024, vdst = lds0 + LV + wid * 1024;
  const int vb0 = (int)lds0 + LV + v_rd_base(lane);
#define DMA_K(t, so) do { const char* b_ = (const char*)Kh + (size_t)(t) * (KVBLK * LDK * 2); const unsigned d_ = (unsigned)__builtin_amdgcn_readfirstlane(kdst + (so)); glds16(kof[0], b_, d_); glds16(kof[1], b_, d_ + 8192u); } while (0)
#define DMA_V(t, so) do { const char* b_ = (const char*)Vh + (size_t)(t) * (KVBLK * LDK * 2); const unsigned d_ = (unsigned)__builtin_amdgcn_readfirstlane(vdst + (so)); glds16(vof[0], b_, d_); glds16(vof[1], b_, d_ + 8192u); } while (0)
#define RESC(a) do { if (__any((a) < 1.f)) { if (hi == 0) al_l[r32] = (a); asm volatile("s_waitcnt lgkmcnt(0)" ::: "memory"); \
    for (int d = 0; d < 4; ++d) for (int r = 0; r < 16; ++r) o[d][r] *= al_l[crow(r, hi)]; } } while (0)
#define KPTR(so) ((const bf16_t*)(lds + LK + (so)))
  f32x16 pA0, pA1, pB0, pB1; float mnA, mnB, alA, alB; bf16x8 pa0, pa1, pa2, pa3; const int NT = seq / KVBLK;
  DMA_K(0, 0); DMA_V(0, 0); DMA_K(1, SLOT);
  WAIT_BAR(0);
  DMA_K(2, 2 * SLOT); DMA_V(1, SLOT);
  qkt(pA0, pA1, KPTR(0), qr, r32, hi); partialSM(pA0, pA1, m_reg, mnA, alA);
  WAIT_BAR(4);
  int s0 = 0, s1 = SLOT, s2 = 2 * SLOT;
#define ROT() do { const int t_ = s0; s0 = s1; s1 = s2; s2 = t_; } while (0)
  for (int j = 1; j + 1 < NT; j += 2) {
    DMA_K(j + 2, s0); DMA_V(j + 1, s2);
    SBAR(); qkt(pB0, pB1, KPTR(s1), qr, r32, hi);
    finishSM(pA0, pA1, alA, l_reg, pa0, pa1, pa2, pa3); SBAR();
    pv_d0(o, vb0 + s0, pa0, pa1, pa2, pa3); partialSM(pB0, pB1, m_reg, mnB, alB);
    RESC(alB);
    WAIT_BAR(4); ROT();
    { const int tk = (j + 3 < NT) ? j + 3 : NT - 1; DMA_K(tk, s0); } DMA_V(j + 2, s2);
    SBAR(); qkt(pA0, pA1, KPTR(s1), qr, r32, hi);
    finishSM(pB0, pB1, alB, l_reg, pa0, pa1, pa2, pa3); SBAR();
    pv_d0(o, vb0 + s0, pa0, pa1, pa2, pa3); partialSM(pA0, pA1, m_reg, mnA, alA);
    RESC(alA);
    WAIT_BAR(4); ROT();
  }
  SBAR(); qkt(pB0, pB1, KPTR(s1), qr, r32, hi);
  finishSM(pA0, pA1, alA, l_reg, pa0, pa1, pa2, pa3); SBAR();
  pv_d0(o, vb0 + s0, pa0, pa1, pa2, pa3); partialSM(pB0, pB1, m_reg, mnB, alB);
  RESC(alB);
  WAIT_BAR(0);
  finishSM(pB0, pB1, alB, l_reg, pa0, pa1, pa2, pa3); SBAR();
  pv_d0(o, vb0 + s1, pa0, pa1, pa2, pa3);
  if (hi == 0) li_l[r32] = l_reg; asm volatile("s_waitcnt lgkmcnt(0)" ::: "memory");
  float rli[16];
#pragma unroll
  for (int r = 0; r < 16; ++r) rli[r] = __builtin_amdgcn_rcpf(li_l[crow(r, hi)]);
  WAIT_BAR(0);
  bf16_t* stg = (bf16_t*)lds + wid * 4096;
#pragma unroll
  for (int r = 0; r < 16; ++r) { const int orow = crow(r, hi);
#pragma unroll
    for (int d0 = 0; d0 < 4; ++d0) { const unsigned w = cvt_pk_bf16(o[d0][r] * rli[r], 0.f); stg[orow * 128 + d0 * 32 + r32] = (bf16_t)(w & 0xffffu); } }
  asm volatile("s_waitcnt lgkmcnt(0)" ::: "memory");
  bf16_t* Ow = Ob + (long)(wid * QBLK) * LDO;
#pragma unroll
  for (int i = 0; i < 8; ++i) { const int row = i * 4 + (lane >> 4), ch = lane & 15; const u32x4 v = *(const u32x4*)(stg + row * 128 + ch * 8); *(u32x4*)(Ow + (long)row * LDO + ch * 8) = v; }
  WAIT_BAR(0);
#undef DMA_K
#undef DMA_V
#undef RESC
#undef KPTR
#undef ROT
}
#undef WAIT_BAR

typedef int v8i __attribute__((ext_vector_type(8)));
typedef int v4i __attribute__((ext_vector_type(4)));
constexpr int SLOT8 = 8192, LK8 = 0, LV8 = 3 * SLOT8, LWS8 = 65536;
constexpr float THR8 = 3.f, POFF8 = 4.f;
#define KSW8(row, byte) ((row) * 128 + (((((byte) >> 4) ^ (((row) >> 1) & 7))) << 4) + ((byte) & 15))
#define VSW8(col, byte) ((col) * 64 + (((((byte) >> 4) ^ (((col) >> 2) & 3))) << 4) + ((byte) & 15))
__device__ __forceinline__ v8i cat8(v4i a, v4i b) { return (v8i){a[0], a[1], a[2], a[3], b[0], b[1], b[2], b[3]}; }
constexpr float THRL8 = THR8 * 1.4426950408889634f;
template <bool FIRST> __device__ __forceinline__ void partialSM8(f32x16& p0, f32x16& p1, float& m_ref, f32x16& negm, float& alpha) {
  float pmax = p0[0]; for (int r = 1; r < 16; ++r) pmax = fmaxf(pmax, p0[r]); for (int r = 0; r < 16; ++r) pmax = fmaxf(pmax, p1[r]);
  { auto rr = __builtin_amdgcn_permlane32_swap(__float_as_uint(pmax), __float_as_uint(pmax), false, false);
    pmax = fmaxf(__uint_as_float(rr[0]), __uint_as_float(rr[1])); }
  const float delta = pmax - POFF8;
  alpha = 1.f;
  if (FIRST || !__builtin_expect(__all(delta <= THRL8), 1)) {
    const float dl = FIRST ? delta : fmaxf(delta, 0.f);
    m_ref += dl;
    for (int r = 0; r < 16; ++r) { p0[r] -= dl; p1[r] -= dl; }
    const float nm = POFF8 - m_ref;
    for (int r = 0; r < 16; ++r) negm[r] = nm;
    if (!FIRST) alpha = __builtin_amdgcn_exp2f(-dl);
  }
  for (int r = 0; r < 16; ++r) p0[r] = __builtin_amdgcn_exp2f(p0[r]);
}
__device__ __forceinline__ void finishSM8(f32x16& p0, f32x16& p1, v8i& pa) {
  for (int r = 0; r < 16; ++r) p1[r] = __builtin_amdgcn_exp2f(p1[r]);
#pragma unroll
  for (int w = 0; w < 4; ++w) { int x = 0; x = __builtin_amdgcn_cvt_pk_fp8_f32(p0[4 * w], p0[4 * w + 1], x, false); x = __builtin_amdgcn_cvt_pk_fp8_f32(p0[4 * w + 2], p0[4 * w + 3], x, true); pa[w] = x; }
#pragma unroll
  for (int w = 0; w < 4; ++w) { int x = 0; x = __builtin_amdgcn_cvt_pk_fp8_f32(p1[4 * w], p1[4 * w + 1], x, false); x = __builtin_amdgcn_cvt_pk_fp8_f32(p1[4 * w + 2], p1[4 * w + 3], x, true); pa[4 + w] = x; }
}
__device__ __forceinline__ void qkt8(f32x16& p0, f32x16& p1, const char* Ks, const v8i* qr, const f32x16& negm, int r32, int hi) {
#pragma unroll
  for (int c = 0; c < 2; ++c) { const int b0 = 64 * c + 32 * hi;
    const v8i a0 = cat8(*reinterpret_cast<const v4i*>(Ks + KSW8(r32, b0)), *reinterpret_cast<const v4i*>(Ks + KSW8(r32, b0 + 16)));
    const v8i a1 = cat8(*reinterpret_cast<const v4i*>(Ks + KSW8(32 + r32, b0)), *reinterpret_cast<const v4i*>(Ks + KSW8(32 + r32, b0 + 16)));
    if (c == 0) { p0 = __builtin_amdgcn_mfma_scale_f32_32x32x64_f8f6f4(a0, qr[c], negm, 0, 0, 0, 0, 0, 0); p1 = __builtin_amdgcn_mfma_scale_f32_32x32x64_f8f6f4(a1, qr[c], negm, 0, 0, 0, 0, 0, 0); }
    else { p0 = __builtin_amdgcn_mfma_scale_f32_32x32x64_f8f6f4(a0, qr[c], p0, 0, 0, 0, 0, 0, 0); p1 = __builtin_amdgcn_mfma_scale_f32_32x32x64_f8f6f4(a1, qr[c], p1, 0, 0, 0, 0, 0, 0); } }
}
__device__ __forceinline__ void pv8(f32x16* o, const char* Vs, v8i pa, int r32, int hi) {
#pragma unroll
  for (int d0 = 0; d0 < 4; ++d0) { const int col = 32 * d0 + r32;
    const v8i b = cat8(*reinterpret_cast<const v4i*>(Vs + VSW8(col, 32 * hi)), *reinterpret_cast<const v4i*>(Vs + VSW8(col, 32 * hi + 16)));
    o[d0] = __builtin_amdgcn_mfma_scale_f32_32x32x64_f8f6f4(pa, b, o[d0], 0, 0, 0, 0, 0, 0); }
  const int one4 = 0x38383838;
  const v8i ones = (v8i){one4, one4, one4, one4, one4, one4, one4, one4};
  o[4] = __builtin_amdgcn_mfma_scale_f32_32x32x64_f8f6f4(pa, ones, o[4], 0, 0, 0, 0, 0, 0);
}
__device__ __forceinline__ void attn_fp8_body(const unsigned char* __restrict__ Q8w, const unsigned char* __restrict__ K8t, const unsigned char* __restrict__ V8t,
                                              bf16_t* __restrict__ Ob, int seq, char* lds, const int tid) {
  const int wid = __builtin_amdgcn_readfirstlane(tid >> 6), lane = tid & 63, r32 = lane & 31, hi = lane >> 5;
  const unsigned lds0 = (unsigned)(uintptr_t)lds;
  float* al_l = (float*)(lds + LWS8) + wid * 64;
  float m_ref = 0.f; f32x16 o[5] = {}; v8i qr[2]; f32x16 negm; for (int r = 0; r < 16; ++r) negm[r] = POFF8; asm volatile("" : "+v"(negm));
  { const unsigned char* qp = Q8w + (size_t)(wid * QBLK + r32) * 1024 + 32 * hi;
#pragma unroll
    for (int c = 0; c < 2; ++c) qr[c] = cat8(*reinterpret_cast<const v4i*>(qp + 64 * c), *reinterpret_cast<const v4i*>(qp + 64 * c + 16)); }
  unsigned kof, vof;
  { const int S = wid * 1024 + lane * 16;
    const int krow = S >> 7, kch = ((S >> 4) & 7) ^ ((krow >> 1) & 7); kof = (unsigned)(krow * 256 + kch * 16);
    const int vcol = S >> 6, vch = ((S >> 4) & 3) ^ ((vcol >> 2) & 3); vof = (unsigned)(vcol * 64 + vch * 16); }
  const unsigned kdst = lds0 + LK8 + wid * 1024, vdst = lds0 + LV8 + wid * 1024;
#define WAIT_BAR(N) asm volatile("s_waitcnt vmcnt(" #N ") lgkmcnt(0)\n\ts_barrier" ::: "memory")
#define DMA_K(t, so) do { const char* b_ = (const char*)K8t + (size_t)(t) * (KVBLK * 256); glds16(kof, b_, (unsigned)__builtin_amdgcn_readfirstlane(kdst + (so))); } while (0)
#define DMA_V(t, so) do { const char* b_ = (const char*)V8t + (size_t)(t) * 8192; glds16(vof, b_, (unsigned)__builtin_amdgcn_readfirstlane(vdst + (so))); } while (0)
#define RESC(a) do { if (__any((a) < 1.f)) { if (hi == 0) al_l[r32] = (a); asm volatile("s_waitcnt lgkmcnt(0)" ::: "memory"); \
    for (int d = 0; d < 5; ++d) for (int r = 0; r < 16; ++r) o[d][r] *= al_l[crow(r, hi)]; } } while (0)
#define KP8(so) ((const char*)(lds + LK8 + (so)))
#define VP8(so) ((const char*)(lds + LV8 + (so)))
  f32x16 pA0, pA1, pB0, pB1; float alA, alB; v8i pa; const int NT = seq / KVBLK;
  DMA_K(0, 0); DMA_V(0, 0); DMA_K(1, SLOT8);
  WAIT_BAR(0);
  DMA_K(2, 2 * SLOT8); DMA_V(1, SLOT8);
  qkt8(pA0, pA1, KP8(0), qr, negm, r32, hi); partialSM8<true>(pA0, pA1, m_ref, negm, alA);
  WAIT_BAR(2);
  int s0 = 0, s1 = SLOT8, s2 = 2 * SLOT8;
#define ROT() do { const int t_ = s0; s0 = s1; s1 = s2; s2 = t_; } while (0)
  for (int j = 1; j + 1 < NT; j += 2) {
    DMA_K(j + 2, s0); DMA_V(j + 1, s2);
    SBAR(); qkt8(pB0, pB1, KP8(s1), qr, negm, r32, hi);
    finishSM8(pA0, pA1, pa); SBAR();
    pv8(o, VP8(s0), pa, r32, hi); partialSM8<false>(pB0, pB1, m_ref, negm, alB);
    RESC(alB);
    WAIT_BAR(2); ROT();
    { const int tk = (j + 3 < NT) ? j + 3 : NT - 1; DMA_K(tk, s0); } DMA_V(j + 2, s2);
    SBAR(); qkt8(pA0, pA1, KP8(s1), qr, negm, r32, hi);
    finishSM8(pB0, pB1, pa); SBAR();
    pv8(o, VP8(s0), pa, r32, hi); partialSM8<false>(pA0, pA1, m_ref, negm, alA);
    RESC(alA);
    WAIT_BAR(2); ROT();
  }
  SBAR(); qkt8(pB0, pB1, KP8(s1), qr, negm, r32, hi);
  finishSM8(pA0, pA1, pa); SBAR();
  pv8(o, VP8(s0), pa, r32, hi); partialSM8<false>(pB0, pB1, m_ref, negm, alB);
  RESC(alB);
  WAIT_BAR(0);
  finishSM8(pB0, pB1, pa); SBAR();
  pv8(o, VP8(s1), pa, r32, hi);
  float rli[16];
#pragma unroll
  for (int r = 0; r < 16; ++r) rli[r] = __builtin_amdgcn_rcpf(o[4][r]);
  WAIT_BAR(0);
  bf16_t* stg = (bf16_t*)lds + wid * 4096;
#pragma unroll
  for (int r = 0; r < 16; ++r) { const int orow = crow(r, hi);
#pragma unroll
    for (int d0 = 0; d0 < 4; ++d0) { const unsigned w = cvt_pk_bf16(o[d0][r] * rli[r], 0.f); stg[orow * 128 + d0 * 32 + r32] = (bf16_t)(w & 0xffffu); } }
  asm volatile("s_waitcnt lgkmcnt(0)" ::: "memory");
  bf16_t* Ow = Ob + (long)(wid * QBLK) * LDO;
#pragma unroll
  for (int i = 0; i < 8; ++i) { const int row = i * 4 + (lane >> 4), ch = lane & 15; const u32x4 v = *(const u32x4*)(stg + row * 128 + ch * 8); *(u32x4*)(Ow + (long)row * LDO + ch * 8) = v; }
  WAIT_BAR(0);
#undef WAIT_BAR
#undef DMA_K
#undef DMA_V
#undef RESC
#undef KP8
#undef VP8
#undef ROT
}
#undef KSWZ
#undef SBAR
}

#define XB_TMO      128
#define XB_XCNT(j)  (256  + 64 * (j))
#define XB_XSUB(j)  (1280 + 64 * (j))
#define XB_XGEN(j)  (2304 + 64 * (j))
#define XB_TOP      3328
#define XB_TOPGEN   3392
#define XCD_BAR_WORDS 3456
#define XB_SPIN_CAP (1u << 18)

__device__ __forceinline__ unsigned xb_ld(unsigned* p)              { return __hip_atomic_load(p, __ATOMIC_RELAXED, __HIP_MEMORY_SCOPE_AGENT); }
__device__ __forceinline__ unsigned xb_add(unsigned* p, unsigned v) { return __hip_atomic_fetch_add(p, v, __ATOMIC_RELAXED, __HIP_MEMORY_SCOPE_AGENT); }
__device__ __forceinline__ unsigned xb_xcc_id() { return (unsigned)__builtin_amdgcn_s_getreg((3 << 11) | 20) & 0xFu; }
#define XB_SPIN(cond, bar) do { unsigned _sp = 0; while (cond) { __builtin_amdgcn_s_sleep(1); \
    if ((++_sp & 255u) == 0u) { if (xb_ld(&(bar)[XB_TMO])) break; if (_sp > XB_SPIN_CAP) { atomicAdd(&(bar)[XB_TMO], 1u); break; } } } } while (0)

struct XcdBarrier {
    unsigned* bar; unsigned x;
    volatile LAS unsigned* st;
};

__device__ __forceinline__ XcdBarrier xcd_barrier_post(unsigned* bar, volatile LAS unsigned* st) {
    XcdBarrier b; b.bar = bar; b.x = xb_xcc_id(); b.st = st;
    if (threadIdx.x == 0) (void)xb_add(&bar[XB_XCNT(b.x)], 1u);
    return b;
}
__device__ __forceinline__ void xcd_barrier_complete(unsigned* bar, unsigned x, unsigned& nloc, unsigned& nx) {
    const unsigned G = gridDim.x * gridDim.y * gridDim.z;
    unsigned sum, cnt, mine, sp = 0u;
    for (;;) {
        sum = 0u; cnt = 0u; mine = 0u;
#pragma unroll
        for (unsigned j = 0; j < 16; ++j) { const unsigned c = xb_ld(&bar[XB_XCNT(j)]); sum += c; cnt += (c > 0u) ? 1u : 0u; mine = (j == x) ? c : mine; }
        if (sum == G) break;
        __builtin_amdgcn_s_sleep(1);
        if ((++sp & 255u) == 0u) { if (xb_ld(&bar[XB_TMO])) break; if (sp > XB_SPIN_CAP) { atomicAdd(&bar[XB_TMO], 1u); break; } }
    }
    nloc = mine > 0u ? mine : 1u; nx = cnt > 0u ? cnt : 1u;
}

__device__ __forceinline__ void xcd_barrier(const XcdBarrier& b) {
    asm volatile("s_waitcnt vmcnt(0)" ::: "memory");
    __syncthreads();
    if (threadIdx.x == 0) {
        unsigned* bar = b.bar;
        __builtin_amdgcn_s_waitcnt(0);
        unsigned nloc = b.st[0], nx = b.st[1];
        if (nloc == 0u) { xcd_barrier_complete(bar, b.x, nloc, nx); b.st[0] = nloc; b.st[1] = nx; }
        const unsigned old = xb_add(&bar[XB_XSUB(b.x)], 1u);
        const unsigned gen = old / nloc;
        if (old + 1u == (gen + 1u) * nloc) {
            __builtin_amdgcn_fence(__ATOMIC_RELEASE, "agent");
            asm volatile("s_waitcnt vmcnt(0)" ::: "memory");
            const unsigned og = xb_add(&bar[XB_TOP], 1u);
            const unsigned tg = og / nx;
            if (og + 1u == (tg + 1u) * nx) xb_add(&bar[XB_TOPGEN], 1u);
            else XB_SPIN(xb_ld(&bar[XB_TOPGEN]) == tg, bar);
            __builtin_amdgcn_fence(__ATOMIC_ACQUIRE, "agent");
            xb_add(&bar[XB_XGEN(b.x)], 1u);
            asm volatile("s_waitcnt vmcnt(0)" ::: "memory");
        } else {
            XB_SPIN(xb_ld(&bar[XB_XGEN(b.x)]) == gen, bar);
            __builtin_amdgcn_fence(__ATOMIC_ACQUIRE, "agent");
            asm volatile("s_waitcnt vmcnt(0)" ::: "memory");
        }
    }
    __syncthreads();
}


constexpr int NPH = 15;
constexpr unsigned GEMM_MASK = (1u << 1) | (1u << 2) | (1u << 3) | (1u << 5) | (1u << 9) | (1u << 10) | (1u << 11) | (1u << 12) | (1u << 13), ALL_MASK = 0x7FFFu;
constexpr unsigned MK_SW = (1u << 1) | (1u << 11), MK_RES = (1u << 2) | (1u << 9) | (1u << 12);
constexpr int LDS_BYTES = 147456;
struct Params { const float* in[26]; float* out; unsigned char* ws; int nprog, pad; unsigned char prog[32]; };

__device__ __forceinline__ void transpose_item(const float* W, int K, int N, const float* gain, bf16_t* WT, int blk, int mul, int add, LAS float* scr, int item, int lane) {
    const int nblk = N / 32, kb = item / nblk, nb = item % nblk, k0 = 64 * kb, n0 = 32 * nb;
    const int drow = (n0 / blk) * mul + add + (n0 % blk);
    float wv[32];
#pragma unroll
    for (int i = 0; i < 32; ++i) wv[i] = W[(size_t)(k0 + 2 * i + (lane >> 5)) * N + n0 + (lane & 31)];
    if (gain) {
#pragma unroll
        for (int i = 0; i < 32; ++i) wv[i] *= gain[k0 + 2 * i + (lane >> 5)];
    }
#pragma unroll
    for (int i = 0; i < 32; ++i) scr[(2 * i + (lane >> 5)) * 33 + (lane & 31)] = wv[i];
    asm volatile("s_waitcnt lgkmcnt(0)" ::: "memory");
    const int c = lane & 7;
#pragma unroll
    for (int j = 0; j < 4; ++j) { const int n = (lane >> 3) + 8 * j; const LAS float* s = scr + (8 * c) * 33 + n;
        u32x4 o; o.x = cvt_pk_bf16(s[0 * 33], s[1 * 33]); o.y = cvt_pk_bf16(s[2 * 33], s[3 * 33]); o.z = cvt_pk_bf16(s[4 * 33], s[5 * 33]); o.w = cvt_pk_bf16(s[6 * 33], s[7 * 33]);
        *(u32x4*)(WT + (size_t)(drow + n) * K + k0 + 8 * c) = o; }
    asm volatile("s_waitcnt lgkmcnt(0)" ::: "memory");
}

template <unsigned MASK> __global__ void __launch_bounds__(512, 2) mega(Params P) {
#define HAS(k) ((MASK >> (k)) & 1u)
    extern __shared__ __attribute__((aligned(16))) unsigned char lds_raw[];
    LAS unsigned char* lds = (LAS unsigned char*)lds_raw;
    cg::grid_group grid = cg::this_grid();
    const int G = gridDim.x, bx = blockIdx.x;
    const int wave0 = __builtin_amdgcn_readfirstlane((int)threadIdx.x >> 6);
    const int vcu = (G % 8 == 0) ? (bx % 8) * (G / 8) + bx / 8 : bx;
    typedef __attribute__((address_space(4))) const Params CParams;
    CParams* const pk = (CParams*)__builtin_amdgcn_kernarg_segment_ptr();
#define SS ((float*)(ws + WS_SS))
#define ROPE ((float*)(ws + WS_ROPE))
#define AGGA ((float*)(ws + WS_AGGA))
#define AGGH ((float*)(ws + WS_AGGH))
#define XB ((bf16_t*)(ws + WS_XB))
#define X ((float*)(ws + WS_X))
#define H ((bf16_t*)(ws + WS_H))
#define RA ((bf16_t*)(ws + WS_RA))
#define BXb ((bf16_t*)(ws + WS_BX))
#define QKV ((bf16_t*)(ws + WS_QKV))
#define PB ((bf16_t*)(ws + WS_PB))
#define U ((bf16_t*)(dob + DO_U))
#define UC ((bf16_t*)(dob + DO_UC))
#define GY ((bf16_t*)(dob + DO_GY))
#define MIX ((bf16_t*)(dob + DO_MIX))
#define PP ((bf16_t*)(dob + DO_PP))

    volatile LAS unsigned* bst = (volatile LAS unsigned*)(lds + 131072 + 512);
    if (threadIdx.x < 2) bst[threadIdx.x] = 0u;
    __syncthreads();
    const XcdBarrier xbar = xcd_barrier_post((unsigned*)(P.ws + WS_BAR), bst);
    const int nprog = P.nprog;
    for (int pi = 0; pi < nprog; ++pi) {
        CParams* pp = pk; asm volatile("" : "+s"(pp));
        unsigned char* const ws = pp->ws; unsigned char* const dob = (unsigned char*)pp->out;
        const int ph = pp->prog[pi];
        int wv_ = wave0; asm volatile("" : "+s"(wv_));
        int tid = wv_ * 64 + (int)__builtin_amdgcn_mbcnt_hi(~0u, __builtin_amdgcn_mbcnt_lo(~0u, 0u)); asm volatile("" : "+v"(tid));
#define THREAD_IDS() const int lane = tid & 63, wave = __builtin_amdgcn_readfirstlane(tid >> 6); const long gt = (long)vcu * 512 + tid, NT_ = (long)G * 512; const int gw = vcu * 8 + wave, NGW = G * 8; (void)lane; (void)gt; (void)NT_; (void)gw; (void)NGW
        if (HAS(0) && ph == 0) {
            THREAD_IDS();
            for (long i = gt; i < 4L * T; i += NT_) SS[i] = 0.f;
            for (long i = gt; i < 320 * 32; i += NT_) {
                const int pos = (int)(i >> 5), j = (int)(i & 31);
                const float inv = exp2f(-(float)j * 0.41524101186092029f);
                const float ang = (float)(pos < 256 ? pos : pos - 256) * inv;
                double rev = (double)ang * 0.15915494309189535; rev -= floor(rev);
                const float fr = (float)rev;
                ROPE[i] = __builtin_amdgcn_cosf(fr); ROPE[320 * 32 + i] = __builtin_amdgcn_sinf(fr);
            }
            for (long i = gt; i < 2 * LRUW; i += NT_) { const float nl = -pp->in[16][i]; ((float*)(ws + WS_C8))[i] = -8.0f * (fmaxf(nl, 0.f) + log1pf(__expf(-fabsf(nl)))) * 1.4426950408889634f; }
            { const float* p = pp->in[1];
              for (long i = gt; i < (long)T * PLED / 8; i += NT_) { const f32x4 a = *(const f32x4*)(p + i * 8), b = *(const f32x4*)(p + i * 8 + 4);
                  u32x4 w; w.x = cvt_pk_bf16(a[0], a[1]); w.y = cvt_pk_bf16(a[2], a[3]); w.z = cvt_pk_bf16(b[0], b[1]); w.w = cvt_pk_bf16(b[2], b[3]); *(u32x4*)(PB + i * 8) = w; } }
            { const float* x = pp->in[0]; const float* g1 = pp->in[2];
              for (int m = gw; m < T; m += 2 * NGW) {
                  const int m2 = (m + NGW < T) ? m + NGW : m;
                  const f32x4* xr = (const f32x4*)(x + (size_t)m * DM) + lane; const f32x4* xr2 = (const f32x4*)(x + (size_t)m2 * DM) + lane;
                  f32x4 v[8], v2[8]; float s = 0.f, s2 = 0.f;
#pragma unroll
                  for (int j = 0; j < 8; ++j) { v[j] = xr[64 * j]; v2[j] = xr2[64 * j]; }
#pragma unroll
                  for (int j = 0; j < 8; ++j) { s += (v[j][0] * v[j][0] + v[j][1] * v[j][1]) + (v[j][2] * v[j][2] + v[j][3] * v[j][3]); s2 += (v2[j][0] * v2[j][0] + v2[j][1] * v2[j][1]) + (v2[j][2] * v2[j][2] + v2[j][3] * v2[j][3]); }
                  const float rs = __builtin_amdgcn_rsqf(wave_sum(s) * (1.0f / DM) + EPS), rs2 = __builtin_amdgcn_rsqf(wave_sum(s2) * (1.0f / DM) + EPS);
                  u32x2* o8 = (u32x2*)(XB + (size_t)m * DM) + lane; u32x2* o82 = (u32x2*)(XB + (size_t)m2 * DM) + lane;
#pragma unroll
                  for (int j = 0; j < 8; ++j) { const f32x4 gg = *((const f32x4*)g1 + lane + 64 * j);
                      u32x2 w; w.x = cvt_pk_bf16(v[j][0] * rs * gg[0], v[j][1] * rs * gg[1]); w.y = cvt_pk_bf16(v[j][2] * rs * gg[2], v[j][3] * rs * gg[3]); o8[64 * j] = w;
                      u32x2 w2; w2.x = cvt_pk_bf16(v2[j][0] * rs2 * gg[0], v2[j][1] * rs2 * gg[1]); w2.y = cvt_pk_bf16(v2[j][2] * rs2 * gg[2], v2[j][3] * rs2 * gg[3]); o82[64 * j] = w2; }
              } }
            { LAS float* scr = (LAS float*)(lds + wave * 16384);
              constexpr int I_FF = (DM / 64) * (DFF / 32), I_IN = (DM / 64) * (INC / 32), I_SQ = (DM / 64) * (DM / 32), I_WP = (PLED / 64) * (DM / 32), I_L = 32 * 8;
              constexpr int NITEMS = 6 * I_FF + I_IN + 2 * I_SQ + I_WP + I_L;
              for (int it = gw; it < NITEMS; it += NGW) {
                  int r = it;
                  if (r < I_FF) { transpose_item(pp->in[3], DM, DFF, nullptr, (bf16_t*)(ws + WS_W13_1), 128, 256, 0, scr, r, lane); continue; } r -= I_FF;
                  if (r < I_FF) { transpose_item(pp->in[4], DM, DFF, nullptr, (bf16_t*)(ws + WS_W13_1), 128, 256, 128, scr, r, lane); continue; } r -= I_FF;
                  if (r < I_FF) { transpose_item(pp->in[5], DFF, DM, nullptr, (bf16_t*)(ws + WS_W2_1), DM, 0, 0, scr, r, lane); continue; } r -= I_FF;
                  if (r < I_FF) { transpose_item(pp->in[19], DM, DFF, pp->in[18], (bf16_t*)(ws + WS_W13_2), 128, 256, 0, scr, r, lane); continue; } r -= I_FF;
                  if (r < I_FF) { transpose_item(pp->in[20], DM, DFF, pp->in[18], (bf16_t*)(ws + WS_W13_2), 128, 256, 128, scr, r, lane); continue; } r -= I_FF;
                  if (r < I_FF) { transpose_item(pp->in[21], DFF, DM, nullptr, (bf16_t*)(ws + WS_W2_2), DM, 0, 0, scr, r, lane); continue; } r -= I_FF;
                  if (r < I_IN) { transpose_item(pp->in[7], DM, INC, pp->in[6], (bf16_t*)(ws + WS_WIN), INC, 0, 0, scr, r, lane); continue; } r -= I_IN;
                  if (r < I_SQ) { transpose_item(pp->in[17], DM, DM, nullptr, (bf16_t*)(ws + WS_WOUT), DM, 0, 0, scr, r, lane); continue; } r -= I_SQ;
                  if (r < I_SQ) { transpose_item(pp->in[23], DM, DM, pp->in[22], (bf16_t*)(ws + WS_WG), DM, 0, 0, scr, r, lane); continue; } r -= I_SQ;
                  if (r < I_WP) { transpose_item(pp->in[24], PLED, DM, nullptr, (bf16_t*)(ws + WS_WP), DM, 0, 0, scr, r, lane); continue; } r -= I_WP;
                  { const int mat = r >> 3, which = mat >> 4, dh = mat & 15;
                    transpose_item((which ? pp->in[14] : pp->in[12]) + (size_t)dh * 128 * 128, 128, 128, nullptr, (bf16_t*)(ws + WS_WL), 128, 0, dh * 256 + which * 128, scr, r & 7, lane); }
              } }
            __syncthreads();
        } else if (HAS(4) && ph == 4) {
            THREAD_IDS();
            { const float* qn = pp->in[8]; const float* kn = pp->in[9];
#define QK_LOAD(I_) (((I_) < (long)T * 160) ? *(const u32x4*)(QKV + (size_t)(((I_) >> 4) / 10) * QKVW + (int)(((I_) >> 4) % 10) * 128 + (int)((I_) & 15) * 8) : (u32x4){0u, 0u, 0u, 0u})
#define QK_TASK(W_, I_) do { const long i = (I_); if (i < (long)T * 160) { \
                  const int sub = (int)(i & 15); const long th = i >> 4; const int hh = (int)(th % 10); const int t = (int)(th / 10); \
                  const u32x4 w = (W_); \
                  const float v0 = bf_lo(w.x), v1 = bf_hi(w.x), v2 = bf_lo(w.y), v3 = bf_hi(w.y), v4 = bf_lo(w.z), v5 = bf_hi(w.z), v6 = bf_lo(w.w), v7 = bf_hi(w.w); \
                  float s = (v0 * v0 + v1 * v1) + (v2 * v2 + v3 * v3) + (v4 * v4 + v5 * v5) + (v6 * v6 + v7 * v7); \
                  s += __shfl_xor(s, 1); s += __shfl_xor(s, 2); s += __shfl_xor(s, 4); s += __shfl_xor(s, 8); \
                  float rs = __builtin_amdgcn_rsqf(s * (1.0f / 128.0f) + EPS); if (hh < 8) rs *= 0.12751743074602467f;   \
                  const float* gn = (hh < 8 ? qn : kn) + sub * 8; \
                  const int sp = t & (SEQ - 1); const int pos = (sub < 8) ? (sp >> 6) : 256 + (sp & 63); \
                  const float* ct = ROPE + pos * 32 + (sub & 7) * 4; const float* st = ct + 320 * 32; \
                  const f32x4 g0 = *(const f32x4*)gn, g1 = *(const f32x4*)(gn + 4), cc = *(const f32x4*)ct, ss = *(const f32x4*)st; \
                  const float a0 = v0 * rs * g0[0], b0 = v1 * rs * g0[1], a1 = v2 * rs * g0[2], b1 = v3 * rs * g0[3], a2 = v4 * rs * g1[0], b2 = v5 * rs * g1[1], a3 = v6 * rs * g1[2], b3 = v7 * rs * g1[3]; \
                  int w0 = 0, w1 = 0; \
                  w0 = __builtin_amdgcn_cvt_pk_fp8_f32(a0 * cc[0] - b0 * ss[0], a0 * ss[0] + b0 * cc[0], w0, false); w0 = __builtin_amdgcn_cvt_pk_fp8_f32(a1 * cc[1] - b1 * ss[1], a1 * ss[1] + b1 * cc[1], w0, true); \
                  w1 = __builtin_amdgcn_cvt_pk_fp8_f32(a2 * cc[2] - b2 * ss[2], a2 * ss[2] + b2 * cc[2], w1, false); w1 = __builtin_amdgcn_cvt_pk_fp8_f32(a3 * cc[3] - b3 * ss[3], a3 * ss[3] + b3 * cc[3], w1, true); \
                  unsigned char* dst8 = (hh < 8) ? (dob + DO_Q8 + (size_t)t * 1024 + hh * 128 + sub * 8) : (dob + DO_K8 + (size_t)t * 256 + (hh - 8) * 128 + sub * 8); \
                  *(u32x2*)dst8 = (u32x2){(unsigned)w0, (unsigned)w1}; } } while (0)
              for (long i0_ = gt; i0_ < (long)T * 160; i0_ += 4 * NT_) {
                  const u32x4 wq0 = QK_LOAD(i0_), wq1 = QK_LOAD(i0_ + NT_), wq2 = QK_LOAD(i0_ + 2 * NT_), wq3 = QK_LOAD(i0_ + 3 * NT_);
                  QK_TASK(wq0, i0_); QK_TASK(wq1, i0_ + NT_); QK_TASK(wq2, i0_ + 2 * NT_); QK_TASK(wq3, i0_ + 3 * NT_);
              } }
#undef QK_LOAD
#undef QK_TASK
            for (long i = gt; i < 262144; i += NT_) {
                const int n = (int)(i & 127), h = (int)((i >> 7) & 1), kvh = (int)((i >> 8) & 1), tile = (int)(i >> 9);
                const bf16_t* src = QKV + (size_t)tile * 64 * QKVW + 1280 + kvh * 128 + n;
                int wv8[8];
#pragma unroll
                for (int w = 0; w < 8; ++w) { float f[4];
#pragma unroll
                    for (int e = 0; e < 4; ++e) { const int sI = 4 * w + e; const int key = ((sI & 3) + 8 * ((sI & 15) >> 2) + 4 * h) + 32 * (sI >> 4); f[e] = __uint_as_float((unsigned)src[(size_t)key * QKVW] << 16); }
                    int x = 0; x = __builtin_amdgcn_cvt_pk_fp8_f32(f[0], f[1], x, false); x = __builtin_amdgcn_cvt_pk_fp8_f32(f[2], f[3], x, true); wv8[w] = x; }
                unsigned char* dv = dob + DO_V8 + ((size_t)((tile >> 8) * 2 + kvh) * 256 + (tile & 255)) * 8192 + n * 64 + h * 32;
                *(u32x4*)dv = (u32x4){(unsigned)wv8[0], (unsigned)wv8[1], (unsigned)wv8[2], (unsigned)wv8[3]};
                *(u32x4*)(dv + 16) = (u32x4){(unsigned)wv8[4], (unsigned)wv8[5], (unsigned)wv8[6], (unsigned)wv8[7]};
            }
            { const float* cw = pp->in[10]; const float* cb = pp->in[11];
#define CV_LOAD(I_, J_) ((((I_) < (long)T * 128) && ((int)(((I_) >> 7) & (SEQ - 1)) - 2 + (J_) >= 0) && ((int)(((I_) >> 7) & (SEQ - 1)) - 2 + (J_) < SEQ)) ? *(const u32x4*)(U + (size_t)((int)((I_) >> 7) - 2 + (J_)) * LRUW + (int)((I_) & 127) * 8) : (u32x4){0u, 0u, 0u, 0u})
#define CV_TAP(W_, J_) do { const u32x4 w = (W_); const f32x4 c0 = *(const f32x4*)(cw + (J_) * LRUW + c8), c1 = *(const f32x4*)(cw + (J_) * LRUW + c8 + 4); \
                  o0[0] += bf_lo(w.x) * c0[0]; o0[1] += bf_hi(w.x) * c0[1]; o0[2] += bf_lo(w.y) * c0[2]; o0[3] += bf_hi(w.y) * c0[3]; o1[0] += bf_lo(w.z) * c1[0]; o1[1] += bf_hi(w.z) * c1[1]; o1[2] += bf_lo(w.w) * c1[2]; o1[3] += bf_hi(w.w) * c1[3]; } while (0)
#define CV_TASK(I_, W0_, W1_, W2_, W3_) do { const long i = (I_); if (i < (long)T * 128) { const int c8 = (int)(i & 127) * 8; const int t = (int)(i >> 7); \
                  f32x4 o0 = *(const f32x4*)(cb + c8), o1 = *(const f32x4*)(cb + c8 + 4); \
                  CV_TAP(W0_, 0); CV_TAP(W1_, 1); CV_TAP(W2_, 2); CV_TAP(W3_, 3); \
                  u32x4 ow; ow.x = cvt_pk_bf16(o0[0], o0[1]); ow.y = cvt_pk_bf16(o0[2], o0[3]); ow.z = cvt_pk_bf16(o1[0], o1[1]); ow.w = cvt_pk_bf16(o1[2], o1[3]); \
                  *(u32x4*)(UC + (size_t)t * LRUW + c8) = ow; } } while (0)
              for (long i0_ = gt; i0_ < (long)T * 128; i0_ += 2 * NT_) {
                  const long i1_ = i0_ + NT_;
                  const u32x4 a0 = CV_LOAD(i0_, 0), a1 = CV_LOAD(i0_, 1), a2 = CV_LOAD(i0_, 2), a3 = CV_LOAD(i0_, 3), b0 = CV_LOAD(i1_, 0), b1 = CV_LOAD(i1_, 1), b2 = CV_LOAD(i1_, 2), b3 = CV_LOAD(i1_, 3);
                  CV_TASK(i0_, a0, a1, a2, a3); CV_TASK(i1_, b0, b1, b2, b3);
              } }
#undef CV_LOAD
#undef CV_TAP
#undef CV_TASK
        } else if (HAS(6) && ph == 6) {
            THREAD_IDS();
            const float* lam = (const float*)(ws + WS_C8);
            for (long i = gt; i < 2L * 2 * NCH * 512; i += NT_) {
                const int cp = (int)(i & 511); const int chunk = (int)((i >> 9) & (NCH - 1)); const int dir = (int)((i >> 16) & 1); const int b = (int)(i >> 17);
                const float k0 = lam[dir * LRUW + 2 * cp], k1 = lam[dir * LRUW + 2 * cp + 1];
                float A0 = 1.f, A1 = 1.f, H0 = 0.f, H1 = 0.f;
                const size_t base = ((size_t)dir * T + (size_t)b * SEQ + (size_t)chunk * CL) * LRUW + 2 * cp;
#pragma unroll 8
                for (int k = 0; k < CL; ++k) { const int tt = dir ? (CL - 1 - k) : k;
                    const unsigned rw = *(const unsigned*)(RA + base + (size_t)tt * LRUW), bw = *(const unsigned*)(BXb + base + (size_t)tt * LRUW);
                    const float a0 = __builtin_amdgcn_exp2f(k0 * bf_lo(rw)), a1 = __builtin_amdgcn_exp2f(k1 * bf_hi(rw));
                    H0 = a0 * H0 + bf_lo(bw); H1 = a1 * H1 + bf_hi(bw); A0 *= a0; A1 *= a1; }
                const size_t ao = (((size_t)b * 2 + dir) * NCH + chunk) * LRUW + 2 * cp;
                *(f32x2*)(AGGA + ao) = (f32x2){A0, A1}; *(f32x2*)(AGGH + ao) = (f32x2){H0, H1};
            }
        } else if (HAS(7) && ph == 7) {
            int seq_ = SEQ; asm volatile("" : "+s"(seq_));
            for (int u = vcu; u < 1024; u += G) {
                const int bkv = u >> 8, rem = u & 255, b = bkv >> 1, kvh = bkv & 1, gq = rem & 3, qb = rem >> 2, h = kvh * 4 + gq;
                const size_t rowb = (size_t)b * SEQ;
                att::attn_fp8_body(dob + DO_Q8 + (rowb + (size_t)qb * 256) * 1024 + h * 128, dob + DO_K8 + rowb * 256 + kvh * 128, dob + DO_V8 + (size_t)(b * 2 + kvh) * 256 * 8192,
                                   MIX + (rowb + (size_t)qb * 256) * DM + h * 128, seq_, (char*)lds_raw, tid);
            }
        } else if (HAS(8) && ph == 8) {
            THREAD_IDS();
            const float* lam = (const float*)(ws + WS_C8);
            for (long i = gt; i < 2L * NCH * 512; i += NT_) {
                const int cp = (int)(i & 511); const int chunk = (int)((i >> 9) & (NCH - 1)); const int b = (int)(i >> 16);
                float kf0, kf1, kb0, kb1;
                kf0 = lam[2 * cp]; kf1 = lam[2 * cp + 1]; kb0 = lam[LRUW + 2 * cp]; kb1 = lam[LRUW + 2 * cp + 1];
                float hf0 = 0.f, hf1 = 0.f, hb0 = 0.f, hb1 = 0.f;
#pragma unroll 8
                for (int j = 0; j < chunk; ++j) { const size_t ao = (((size_t)b * 2 + 0) * NCH + j) * LRUW + 2 * cp; const f32x2 a = *(const f32x2*)(AGGA + ao), hh = *(const f32x2*)(AGGH + ao); hf0 = a[0] * hf0 + hh[0]; hf1 = a[1] * hf1 + hh[1]; }
#pragma unroll 8
                for (int j = NCH - 1; j > chunk; --j) { const size_t ao = (((size_t)b * 2 + 1) * NCH + j) * LRUW + 2 * cp; const f32x2 a = *(const f32x2*)(AGGA + ao), hh = *(const f32x2*)(AGGH + ao); hb0 = a[0] * hb0 + hh[0]; hb1 = a[1] * hb1 + hh[1]; }
                const size_t row0 = (size_t)b * SEQ + (size_t)chunk * CL;
                const size_t fbase = row0 * LRUW + 2 * cp, bbase = ((size_t)T + row0) * LRUW + 2 * cp;
                bf16_t* mx = MIX + row0 * DM + 1024 + 2 * cp;
                {
                    unsigned rwc[8], bwc[8], rwn[8], bwn[8];
#pragma unroll
                    for (int u = 0; u < 8; ++u) { rwc[u] = *(const unsigned*)(RA + fbase + (size_t)u * LRUW); bwc[u] = *(const unsigned*)(BXb + fbase + (size_t)u * LRUW); }
                    for (int k0 = 0; k0 < CL; k0 += 8) {
                        const int kn = (k0 + 8 < CL) ? k0 + 8 : k0;
#pragma unroll
                        for (int u = 0; u < 8; ++u) { rwn[u] = *(const unsigned*)(RA + fbase + (size_t)(kn + u) * LRUW); bwn[u] = *(const unsigned*)(BXb + fbase + (size_t)(kn + u) * LRUW); }
#pragma unroll
                        for (int u = 0; u < 8; ++u) {
                            hf0 = __builtin_amdgcn_exp2f(kf0 * bf_lo(rwc[u])) * hf0 + bf_lo(bwc[u]); hf1 = __builtin_amdgcn_exp2f(kf1 * bf_hi(rwc[u])) * hf1 + bf_hi(bwc[u]);
                            *(unsigned*)(mx + (size_t)(k0 + u) * DM) = cvt_pk_bf16(hf0, hf1); }
#pragma unroll
                        for (int u = 0; u < 8; ++u) { rwc[u] = rwn[u]; bwc[u] = bwn[u]; }
                    }
                }
                asm volatile("s_waitcnt vmcnt(0)" ::: "memory");
                {
                    unsigned rwc[8], bwc[8], fwc[8], gwc[8], rwn[8], bwn[8], fwn[8], gwn[8];
#pragma unroll
                    for (int u = 0; u < 8; ++u) { const int k = CL - 1 - u; rwc[u] = *(const unsigned*)(RA + bbase + (size_t)k * LRUW); bwc[u] = *(const unsigned*)(BXb + bbase + (size_t)k * LRUW);
                        fwc[u] = *(const unsigned*)(mx + (size_t)k * DM); gwc[u] = *(const unsigned*)(GY + (row0 + k) * LRUW + 2 * cp); }
                    for (int k0 = CL - 1; k0 >= 0; k0 -= 8) {
                        const int kn = (k0 - 8 >= 0) ? k0 - 8 : k0;
#pragma unroll
                        for (int u = 0; u < 8; ++u) { const int k = kn - u; rwn[u] = *(const unsigned*)(RA + bbase + (size_t)k * LRUW); bwn[u] = *(const unsigned*)(BXb + bbase + (size_t)k * LRUW);
                            fwn[u] = *(const unsigned*)(mx + (size_t)k * DM); gwn[u] = *(const unsigned*)(GY + (row0 + k) * LRUW + 2 * cp); }
#pragma unroll
                        for (int u = 0; u < 8; ++u) { const int k = k0 - u;
                            hb0 = __builtin_amdgcn_exp2f(kb0 * bf_lo(rwc[u])) * hb0 + bf_lo(bwc[u]); hb1 = __builtin_amdgcn_exp2f(kb1 * bf_hi(rwc[u])) * hb1 + bf_hi(bwc[u]);
                            *(unsigned*)(mx + (size_t)k * DM) = cvt_pk_bf16((bf_lo(fwc[u]) + hb0) * bf_lo(gwc[u]), (bf_hi(fwc[u]) + hb1) * bf_hi(gwc[u])); }
#pragma unroll
                        for (int u = 0; u < 8; ++u) { rwc[u] = rwn[u]; bwc[u] = bwn[u]; fwc[u] = fwn[u]; gwc[u] = gwn[u]; }
                    }
                }
            }
        } else if (HAS(14) && ph == 14) {
            THREAD_IDS();
            const float* gf = pp->in[25]; const float* ss4 = SS + 3 * T;
            for (int m = gw; m < T; m += NGW) {
                const float rs = __builtin_amdgcn_rsqf(ss4[m] * (1.0f / DM) + EPS);
                const f32x4* xr = (const f32x4*)(X + (size_t)m * DM) + lane; f32x4* orow = (f32x4*)(pp->out + (size_t)m * DM) + lane;
#pragma unroll
                for (int j = 0; j < 8; ++j) { const f32x4 gg = *((const f32x4*)gf + lane + 64 * j); orow[64 * j] = xr[64 * j] * rs * gg; }
            }
        } else if (MASK & GEMM_MASK) {
            pg8::Gemm g; g.M = T; g.amask = 0; g.astride = 0;
            pg8::StaticOrder S;
#define EPI_INIT(E) do { E.alpha = 1.f; E.base = nullptr; E.Xo = nullptr; E.XBo = nullptr; E.ss_out = nullptr; E.ss_in = nullptr; E.O0 = nullptr; E.O1 = nullptr; E.O2 = nullptr; E.aux = nullptr; E.ba = nullptr; E.bi = nullptr; E.lam = nullptr; } while (0)
            if ((HAS(1) || HAS(11)) && (ph == 1 || ph == 11)) {
                pg8::Epi<pg8::M_SWIGLU> E; EPI_INIT(E);
                g.A = XB; g.Bt = (bf16_t*)(ws + (ph == 1 ? WS_W13_1 : WS_W13_2)); g.N = 2 * DFF; g.K = DM; g.lda = DM; g.ldb = DM; E.O0 = H; E.ss_in = (ph == 1) ? nullptr : SS + T;
                S.init(g.M, g.N, G, bx); pg8::gemm_phase(lds, g, S, E, tid);
            } else if ((HAS(2) || HAS(9) || HAS(12)) && (ph == 2 || ph == 9 || ph == 12)) {
                pg8::Epi<pg8::M_RESID> E; EPI_INIT(E); E.Xo = X; E.XBo = XB;
                if (ph == 2) { g.A = H; g.Bt = (bf16_t*)(ws + WS_W2_1); g.K = DFF; g.lda = DFF; g.ldb = DFF; E.base = pp->in[0]; E.alpha = 0.5f; E.ss_out = SS; }
                else if (ph == 9) { g.A = MIX; g.Bt = (bf16_t*)(ws + WS_WOUT); g.K = DM; g.lda = DM; g.ldb = DM; E.base = X; E.alpha = 1.f; E.ss_out = SS + T; }
                else { g.A = H; g.Bt = (bf16_t*)(ws + WS_W2_2); g.K = DFF; g.lda = DFF; g.ldb = DFF; E.base = X; E.alpha = 0.5f; E.ss_out = SS + 2 * T; }
                g.N = DM;
                S.init(g.M, g.N, G, bx); pg8::gemm_phase(lds, g, S, E, tid);
            } else if (HAS(3) && ph == 3) {
                pg8::Epi<pg8::M_WIN> E; EPI_INIT(E);
                g.A = XB; g.Bt = (bf16_t*)(ws + WS_WIN); g.N = INC; g.K = DM; g.lda = DM; g.ldb = DM; E.ss_in = SS; E.O0 = QKV; E.O1 = U; E.O2 = GY;
                S.init(g.M, g.N, G, bx); pg8::gemm_phase(lds, g, S, E, tid);
            } else if (HAS(5) && ph == 5) {
                pg8::Epi<pg8::M_GATES> E; EPI_INIT(E);
                g.A = UC; g.Bt = (bf16_t*)(ws + WS_WL); g.N = 4096; g.K = 128; g.lda = LRUW; g.ldb = 128; g.amask = 7; g.astride = 256; E.O0 = RA; E.O1 = BXb; E.aux = UC;
                E.ba = pp->in[13]; E.bi = pp->in[15]; E.lam = (const float*)(ws + WS_C8);
                S.init(g.M, g.N, G, bx); pg8::gemm_phase(lds, g, S, E, tid);
            } else if (HAS(10) && ph == 10) {
                pg8::Epi<pg8::M_PLAIN> E; EPI_INIT(E);
                g.A = PB; g.Bt = (bf16_t*)(ws + WS_WP); g.N = DM; g.K = PLED; g.lda = PLED; g.ldb = PLED; E.O0 = PP;
                S.init(g.M, g.N, G, bx); pg8::gemm_phase(lds, g, S, E, tid);
            } else if (HAS(13)) {
                pg8::Epi<pg8::M_PLE> E; EPI_INIT(E);
                g.A = XB; g.Bt = (bf16_t*)(ws + WS_WG); g.N = DM; g.K = DM; g.lda = DM; g.ldb = DM; E.Xo = X; E.base = X; E.ss_in = SS + 2 * T; E.ss_out = SS + 3 * T; E.aux = PP;
                S.init(g.M, g.N, G, bx); pg8::gemm_phase(lds, g, S, E, tid);
            }
#undef EPI_INIT
        }
        if (pi + 1 < nprog && ph != 7 && ph != 9) { if (pi == 0) grid.sync(); else xcd_barrier(xbar); }
    }
}

#if MK_ONE_LAUNCH
#define MEGA_MAIN mega<ALL_MASK>
#else
#define MEGA_MAIN mega<MK_SW>
#endif
extern "C" void kernel_launch(void* const* d_in, const int* in_sizes, int n_in, void* d_out, int out_size, void* d_ws, size_t ws_size, hipStream_t stream) {
    static int grid = 0;
    if (grid == 0) {
        if (n_in != 26 || in_sizes[0] != T * DM || out_size != T * DM || ws_size < WS_END) { fprintf(stderr, "kernel_launch: shape/workspace mismatch (n_in %d, ws %zu)\n", n_in, ws_size); grid = -1; return; }
        int dev = 0, cus = 0, per_cu = 0;
        (void)hipGetDevice(&dev); (void)hipDeviceGetAttribute(&cus, hipDeviceAttributeMultiprocessorCount, dev);
        bool ok = hipFuncSetAttribute((const void*)MEGA_MAIN, hipFuncAttributeMaxDynamicSharedMemorySize, LDS_BYTES) == hipSuccess;
#if !MK_ONE_LAUNCH
        ok = ok && hipFuncSetAttribute((const void*)mega<1u << 0>, hipFuncAttributeMaxDynamicSharedMemorySize, LDS_BYTES) == hipSuccess;
        ok = ok && hipFuncSetAttribute((const void*)mega<1u << 4>, hipFuncAttributeMaxDynamicSharedMemorySize, LDS_BYTES) == hipSuccess;
        ok = ok && hipFuncSetAttribute((const void*)mega<1u << 6>, hipFuncAttributeMaxDynamicSharedMemorySize, LDS_BYTES) == hipSuccess;
        ok = ok && hipFuncSetAttribute((const void*)mega<1u << 7>, hipFuncAttributeMaxDynamicSharedMemorySize, LDS_BYTES) == hipSuccess;
        ok = ok && hipFuncSetAttribute((const void*)mega<1u << 8>, hipFuncAttributeMaxDynamicSharedMemorySize, LDS_BYTES) == hipSuccess;
        ok = ok && hipFuncSetAttribute((const void*)mega<1u << 14>, hipFuncAttributeMaxDynamicSharedMemorySize, LDS_BYTES) == hipSuccess;
        ok = ok && hipFuncSetAttribute((const void*)mega<MK_RES>, hipFuncAttributeMaxDynamicSharedMemorySize, LDS_BYTES) == hipSuccess;
        ok = ok && hipFuncSetAttribute((const void*)mega<1u << 3>, hipFuncAttributeMaxDynamicSharedMemorySize, LDS_BYTES) == hipSuccess;
        ok = ok && hipFuncSetAttribute((const void*)mega<1u << 5>, hipFuncAttributeMaxDynamicSharedMemorySize, LDS_BYTES) == hipSuccess;
        ok = ok && hipFuncSetAttribute((const void*)mega<1u << 10>, hipFuncAttributeMaxDynamicSharedMemorySize, LDS_BYTES) == hipSuccess;
        ok = ok && hipFuncSetAttribute((const void*)mega<1u << 13>, hipFuncAttributeMaxDynamicSharedMemorySize, LDS_BYTES) == hipSuccess;
#endif
        if (!ok) { fprintf(stderr, "kernel_launch: hipFuncSetAttribute failed\n"); grid = -1; return; }
        if (hipOccupancyMaxActiveBlocksPerMultiprocessor(&per_cu, (const void*)MEGA_MAIN, 512, LDS_BYTES) != hipSuccess || per_cu < 1) { fprintf(stderr, "kernel_launch: occupancy query gives %d\n", per_cu); per_cu = 1; }
        (void)hipGetLastError();
        grid = cus * per_cu;
    }
    if (grid < 0) return;
    Params p{};
    for (int i = 0; i < 26; ++i) p.in[i] = (const float*)d_in[i];
    p.out = (float*)d_out; p.ws = (unsigned char*)d_ws;
#if MK_ONE_LAUNCH
#ifdef MK_PROG
    { const unsigned char prog[] = {MK_PROG}; p.nprog = (int)sizeof(prog); for (int i = 0; i < p.nprog; ++i) p.prog[i] = prog[i]; }
#else
    p.nprog = NPH; for (int i = 0; i < NPH; ++i) p.prog[i] = (unsigned char)i;
#endif
    void* args[] = {&p};
    if (hipMemsetAsync((char*)d_ws + WS_BAR, 0, BAR_BYTES, stream) != hipSuccess) { fprintf(stderr, "kernel_launch: memset of barrier words failed\n"); return; }
    hipError_t e = hipLaunchCooperativeKernel((const void*)MEGA_MAIN, dim3(grid), dim3(512), args, LDS_BYTES, stream);
    if (e != hipSuccess) fprintf(stderr, "cooperative launch failed: %s (grid %d)\n", hipGetErrorString(e), grid);
#else
    for (int ph = 0; ph < NPH; ++ph) {
        p.nprog = 1; p.prog[0] = (unsigned char)ph;
        switch (ph) {
        case 0:  hipLaunchKernelGGL(mega<1u << 0>, dim3(grid), dim3(512), LDS_BYTES, stream, p); break;
        case 4:  hipLaunchKernelGGL(mega<1u << 4>, dim3(grid), dim3(512), LDS_BYTES, stream, p); break;
        case 6:  hipLaunchKernelGGL(mega<1u << 6>, dim3(grid), dim3(512), LDS_BYTES, stream, p); break;
        case 7:  hipLaunchKernelGGL(mega<1u << 7>, dim3(grid), dim3(512), LDS_BYTES, stream, p); break;
        case 8:  hipLaunchKernelGGL(mega<1u << 8>, dim3(grid), dim3(512), LDS_BYTES, stream, p); break;
        case 14: hipLaunchKernelGGL(mega<1u << 14>, dim3(grid), dim3(512), LDS_BYTES, stream, p); break;
        case 1: case 11: hipLaunchKernelGGL(mega<MK_SW>, dim3(grid), dim3(512), LDS_BYTES, stream, p); break;
        case 2: case 9: case 12: hipLaunchKernelGGL(mega<MK_RES>, dim3(grid), dim3(512), LDS_BYTES, stream, p); break;
        case 3:  hipLaunchKernelGGL(mega<1u << 3>, dim3(grid), dim3(512), LDS_BYTES, stream, p); break;
        case 5:  hipLaunchKernelGGL(mega<1u << 5>, dim3(grid), dim3(512), LDS_BYTES, stream, p); break;
        case 10: hipLaunchKernelGGL(mega<1u << 10>, dim3(grid), dim3(512), LDS_BYTES, stream, p); break;
        default: hipLaunchKernelGGL(mega<1u << 13>, dim3(grid), dim3(512), LDS_BYTES, stream, p); break;
        }
    }
#endif
}
```

```cpp
#include <hip/hip_runtime.h>
#include <hip/hip_cooperative_groups.h>
#include <cstdio>
#include <cstdint>
namespace cg = cooperative_groups;

#ifndef MK_ONE_LAUNCH
#define MK_ONE_LAUNCH 1
#endif

#define LAS __attribute__((address_space(3)))
typedef unsigned short bf16_t;
typedef short bf16x8 __attribute__((ext_vector_type(8)));
typedef short s16x4 __attribute__((ext_vector_type(4)));
typedef float f32x4 __attribute__((ext_vector_type(4)));
typedef float f32x2 __attribute__((ext_vector_type(2)));
typedef float f32x16 __attribute__((ext_vector_type(16)));
typedef unsigned u32x4 __attribute__((ext_vector_type(4)));
typedef unsigned u32x2 __attribute__((ext_vector_type(2)));

constexpr int BATCH = 2, SEQ = 16384, DM = 2048, T = BATCH * SEQ, DFF = 5632, INC = 3584, PLED = 256;
constexpr int LRUW = 1024, QKVW = 1536, NCH = 128, CL = 128;
constexpr float EPS = 1e-6f;

constexpr size_t MiB = 1u << 20;
constexpr size_t WS_SS = 0;
constexpr size_t WS_ROPE = 1 * MiB, WS_C8 = 1 * MiB + 128 * 1024;
constexpr size_t WS_BAR = 1 * MiB + 512 * 1024, BAR_BYTES = 16384;
constexpr size_t WS_AGGA = 2 * MiB, WS_AGGH = 4 * MiB;
constexpr size_t WS_W13_1 = 8 * MiB, WS_W2_1 = 52 * MiB, WS_W13_2 = 74 * MiB, WS_W2_2 = 118 * MiB;
constexpr size_t WS_WIN = 140 * MiB, WS_WOUT = 154 * MiB, WS_WG = 162 * MiB, WS_WP = 170 * MiB, WS_WL = 171 * MiB;
constexpr size_t WS_PB = 172 * MiB;
constexpr size_t WS_XB = 188 * MiB;
constexpr size_t WS_X = 316 * MiB;
constexpr size_t WS_H = 572 * MiB;
constexpr size_t WS_RA = WS_H, WS_BX = WS_H + 128 * MiB, WS_QKV = WS_H + 256 * MiB;
constexpr size_t WS_END = 924 * MiB;
constexpr size_t DO_U = 0, DO_UC = 64 * MiB, DO_GY = 128 * MiB, DO_MIX = 0, DO_PP = 128 * MiB;
constexpr size_t DO_Q8 = 192 * MiB, DO_K8 = 224 * MiB, DO_V8 = 232 * MiB;

__device__ __forceinline__ unsigned cvt_pk_bf16(float lo, float hi) { unsigned r; asm volatile("v_cvt_pk_bf16_f32 %0, %1, %2" : "=v"(r) : "v"(lo), "v"(hi)); return r; }
__device__ __forceinline__ float bf_lo(unsigned w) { return __uint_as_float(w << 16); }
__device__ __forceinline__ float bf_hi(unsigned w) { return __uint_as_float(w & 0xffff0000u); }
__device__ __forceinline__ float sigmoidf_(float x) { return __builtin_amdgcn_rcpf(1.0f + __expf(-x)); }
__device__ __forceinline__ float wave_sum(float v) {
#pragma unroll
    for (int o = 1; o < 64; o <<= 1) v += __shfl_xor(v, o);
    return v;
}

namespace pg8 {
constexpr int BM = 256, BK = 64, HALF = 128, HTB = HALF * BK * 2, STAGE_BYTES = 8 * HTB, NXCD = 8, WGM = 8;
__host__ __device__ __forceinline__ int lds_byte(int r, int c) { const int st = (r >> 4) * 2 + (c >> 5), rr = r & 15, cc = c & 31, ob = rr * 64 + cc * 2; return st * 1024 + (ob ^ (((ob >> 9) & 1) << 5)); }
__host__ __device__ __forceinline__ void stage_rc(int b, int& R, int& C) { const int st = b / 1024, sb = b % 1024, swz = sb ^ (((sb >> 9) & 1) << 5); R = (st >> 1) * 16 + swz / 64; C = (st & 1) * 32 + (swz % 64) / 2; }
__host__ __device__ __forceinline__ int perm32(int rho) { const int n = rho >> 4, i = rho & 15; return 8 * (i >> 2) + 4 * n + (i & 3); }

struct Unit { int pm, pn; };
struct Gemm { const bf16_t* A; const bf16_t* Bt; int M, N, K, lda, ldb, amask, astride; };

struct StaticOrder {
    int nM, nN, nwg, G, c;
    __device__ void init(int M, int N, int G_, int c_) { nM = M / BM; nN = N / BM; nwg = nM * nN; G = G_; c = c_; }
    __device__ bool next(int i, Unit& u) const {
        const long L = (long)i * G + c; if (L >= nwg) return false;
        int wgid = (int)L; { const int q = nwg / NXCD, r = nwg % NXCD, xcd = wgid % NXCD, off = wgid / NXCD; wgid = (xcd < r ? xcd * (q + 1) : r * (q + 1) + (xcd - r) * q) + off; }
        const int nig = WGM * nN, gid = wgid / nig, fm = gid * WGM, gsz = (nM - fm) < WGM ? (nM - fm) : WGM;
        u.pm = fm + ((wgid % nig) % gsz); u.pn = (wgid % nig) / gsz; return true;
    }
};

enum { M_SWIGLU = 0, M_RESID = 1, M_WIN = 2, M_GATES = 3, M_PLAIN = 4, M_PLE = 5 };
template <int mode> struct Epi {
    float alpha;
    const float* base; float* Xo; bf16_t* XBo; float* ss_out; const float* ss_in;
    bf16_t* O0; bf16_t* O1; bf16_t* O2; const bf16_t* aux;
    const float* ba; const float* bi; const float* lam;
    __device__ __forceinline__ float rs_of(int row) const { return __builtin_amdgcn_rsqf(ss_in[row] * (1.0f / DM) + EPS); }
    __device__ __forceinline__ void operator()(const f32x4 (&acc)[2][2][4][2], const Unit& u, int wr, int wc, int fr, int fq) const {
        const int row0 = u.pm * BM + wr * 64 + fr;
        const int cw = wc * 32 + 8 * fq;
        if constexpr (mode == M_SWIGLU) {
#pragma unroll
            for (int ai = 0; ai < 2; ++ai)
#pragma unroll
                for (int m = 0; m < 4; ++m) {
                    const int row = row0 + ai * HALF + m * 16;
                    const float s = ss_in ? rs_of(row) : 1.0f;
                    u32x4 w; float v[8];
#pragma unroll
                    for (int n = 0; n < 2; ++n)
#pragma unroll
                        for (int e = 0; e < 4; ++e) { const float a = acc[ai][0][m][n][e] * s, b = acc[ai][1][m][n][e] * s; v[4 * n + e] = a * b * sigmoidf_(a); }
                    w.x = cvt_pk_bf16(v[0], v[1]); w.y = cvt_pk_bf16(v[2], v[3]); w.z = cvt_pk_bf16(v[4], v[5]); w.w = cvt_pk_bf16(v[6], v[7]);
                    __builtin_nontemporal_store(w, (u32x4*)(O0 + (size_t)row * DFF + u.pn * HALF + cw));
                }
        } else if constexpr (mode == M_RESID || mode == M_PLE) {
            f32x4 cx[2][2], nx[2][2]; u32x4 cp_[2], np_[2];
#define RP_LOAD(dx_, dp_, it_) do { const int row_ = row0 + ((it_) >> 2) * HALF + ((it_) & 3) * 16; _Pragma("unroll") for (int bj = 0; bj < 2; ++bj) { const size_t off_ = (size_t)row_ * DM + u.pn * BM + bj * HALF + cw; \
                dx_[bj][0] = *(const f32x4*)(base + off_); dx_[bj][1] = *(const f32x4*)(base + off_ + 4); if (mode == M_PLE) dp_[bj] = *(const u32x4*)(aux + off_); } } while (0)
            RP_LOAD(cx, cp_, 0);
#pragma unroll
            for (int it = 0; it < 8; ++it) {
                const int ai = it >> 2, m = it & 3;
                const int row = row0 + ai * HALF + m * 16;
                if (it + 1 < 8) RP_LOAD(nx, np_, it + 1);
                const float s = (mode == M_PLE) ? rs_of(row) : 1.0f;
                float sq = 0.f;
#pragma unroll
                for (int bj = 0; bj < 2; ++bj) {
                    const size_t off = (size_t)row * DM + u.pn * BM + bj * HALF + cw;
                    f32x4 x0 = cx[bj][0], x1 = cx[bj][1];
                    if (mode == M_PLE) {
                        const u32x4 pw = cp_[bj];
                        const f32x4 a0 = acc[ai][bj][m][0] * s, a1 = acc[ai][bj][m][1] * s;
                        x0[0] += sigmoidf_(a0[0]) * bf_lo(pw.x); x0[1] += sigmoidf_(a0[1]) * bf_hi(pw.x); x0[2] += sigmoidf_(a0[2]) * bf_lo(pw.y); x0[3] += sigmoidf_(a0[3]) * bf_hi(pw.y);
                        x1[0] += sigmoidf_(a1[0]) * bf_lo(pw.z); x1[1] += sigmoidf_(a1[1]) * bf_hi(pw.z); x1[2] += sigmoidf_(a1[2]) * bf_lo(pw.w); x1[3] += sigmoidf_(a1[3]) * bf_hi(pw.w);
                    } else {
                        x0 += acc[ai][bj][m][0] * alpha; x1 += acc[ai][bj][m][1] * alpha;
                    }
                    __builtin_nontemporal_store(x0, (f32x4*)(Xo + off)); __builtin_nontemporal_store(x1, (f32x4*)(Xo + off + 4));
                    if (mode == M_RESID) { u32x4 w; w.x = cvt_pk_bf16(x0[0], x0[1]); w.y = cvt_pk_bf16(x0[2], x0[3]); w.z = cvt_pk_bf16(x1[0], x1[1]); w.w = cvt_pk_bf16(x1[2], x1[3]); *(u32x4*)(XBo + off) = w; }
                    sq += (x0[0] * x0[0] + x0[1] * x0[1]) + (x0[2] * x0[2] + x0[3] * x0[3]) + (x1[0] * x1[0] + x1[1] * x1[1]) + (x1[2] * x1[2] + x1[3] * x1[3]);
                }
                sq += __shfl_xor(sq, 16); sq += __shfl_xor(sq, 32);
                if (fq == 0) __hip_atomic_fetch_add(ss_out + row, sq, __ATOMIC_RELAXED, __HIP_MEMORY_SCOPE_AGENT);
#pragma unroll
                for (int bj = 0; bj < 2; ++bj) { cx[bj][0] = nx[bj][0]; cx[bj][1] = nx[bj][1]; cp_[bj] = np_[bj]; }
            }
#undef RP_LOAD
        } else if constexpr (mode == M_WIN) {
            const int pn = u.pn;
            bf16_t* dst; int ld, c0;
            if (pn < 6) { dst = O0; ld = QKVW; c0 = pn * BM; } else if (pn < 10) { dst = O1; ld = LRUW; c0 = (pn - 6) * BM; } else { dst = O2; ld = LRUW; c0 = (pn - 10) * BM; }
            const bool act = pn >= 10;
#pragma unroll
            for (int ai = 0; ai < 2; ++ai)
#pragma unroll
                for (int m = 0; m < 4; ++m) {
                    const int row = row0 + ai * HALF + m * 16;
                    const float s = rs_of(row);
#pragma unroll
                    for (int bj = 0; bj < 2; ++bj) {
                        float v[8];
#pragma unroll
                        for (int n = 0; n < 2; ++n)
#pragma unroll
                            for (int e = 0; e < 4; ++e) { float x = acc[ai][bj][m][n][e] * s;
                                if (act) { const float z = 1.5957691216f * (x + 0.044715f * x * x * x); x = x * sigmoidf_(z); }
                                v[4 * n + e] = x; }
                        u32x4 w; w.x = cvt_pk_bf16(v[0], v[1]); w.y = cvt_pk_bf16(v[2], v[3]); w.z = cvt_pk_bf16(v[4], v[5]); w.w = cvt_pk_bf16(v[6], v[7]);
                        *(u32x4*)(dst + (size_t)row * ld + c0 + bj * HALF + cw) = w;
                    }
                }
        } else if constexpr (mode == M_GATES) {
            const int dir = u.pn >> 3, h = u.pn & 7;
            const int chb = h * HALF + cw;
            f32x4 vba[2], vbi[2], c8[2];
#pragma unroll
            for (int n = 0; n < 2; ++n) { vba[n] = *(const f32x4*)(ba + dir * LRUW + chb + 4 * n); vbi[n] = *(const f32x4*)(bi + dir * LRUW + chb + 4 * n); c8[n] = *(const f32x4*)(lam + dir * LRUW + chb + 4 * n); }
            u32x4 uwv[2][4];
#pragma unroll
            for (int ai = 0; ai < 2; ++ai)
#pragma unroll
                for (int m = 0; m < 4; ++m) uwv[ai][m] = *(const u32x4*)(aux + (size_t)(row0 + ai * HALF + m * 16) * LRUW + chb);
#pragma unroll
            for (int ai = 0; ai < 2; ++ai)
#pragma unroll
                for (int m = 0; m < 4; ++m) {
                    const int row = row0 + ai * HALF + m * 16;
                    const u32x4 uw = uwv[ai][m];
                    u32x4 wr_, wb_;
#pragma unroll
                    for (int n = 0; n < 2; ++n) {
                        float rr[4], bx[4];
#pragma unroll
                        for (int e = 0; e < 4; ++e) {
                            const unsigned uword = (n == 0) ? (e < 2 ? uw.x : uw.y) : (e < 2 ? uw.z : uw.w);
                            const float ucv = (e & 1) ? bf_hi(uword) : bf_lo(uword);
                            const float r = sigmoidf_(acc[ai][0][m][n][e] + vba[n][e]), ig = sigmoidf_(acc[ai][1][m][n][e] + vbi[n][e]);
                            const float a2 = __builtin_amdgcn_exp2f(2.0f * c8[n][e] * r);
                            rr[e] = r; bx[e] = __builtin_amdgcn_sqrtf(fmaxf(1.0f - a2, 0.f)) * ig * ucv; }
                        if (n == 0) { wr_.x = cvt_pk_bf16(rr[0], rr[1]); wr_.y = cvt_pk_bf16(rr[2], rr[3]); wb_.x = cvt_pk_bf16(bx[0], bx[1]); wb_.y = cvt_pk_bf16(bx[2], bx[3]); }
                        else { wr_.z = cvt_pk_bf16(rr[0], rr[1]); wr_.w = cvt_pk_bf16(rr[2], rr[3]); wb_.z = cvt_pk_bf16(bx[0], bx[1]); wb_.w = cvt_pk_bf16(bx[2], bx[3]); }
                    }
                    *(u32x4*)(O0 + ((size_t)dir * T + row) * LRUW + chb) = wr_;
                    *(u32x4*)(O1 + ((size_t)dir * T + row) * LRUW + chb) = wb_;
                }
        } else {
#pragma unroll
            for (int ai = 0; ai < 2; ++ai)
#pragma unroll
                for (int m = 0; m < 4; ++m) {
                    const int row = row0 + ai * HALF + m * 16;
#pragma unroll
                    for (int bj = 0; bj < 2; ++bj) {
                        const f32x4 v0 = acc[ai][bj][m][0], v1 = acc[ai][bj][m][1];
                        u32x4 w; w.x = cvt_pk_bf16(v0[0], v0[1]); w.y = cvt_pk_bf16(v0[2], v0[3]); w.z = cvt_pk_bf16(v1[0], v1[1]); w.w = cvt_pk_bf16(v1[2], v1[3]);
                        *(u32x4*)(O0 + (size_t)row * DM + u.pn * BM + bj * HALF + cw) = w;
                    }
                }
        }
    }
};

template <class Epi> __device__ __forceinline__ void gemm_phase(LAS unsigned char* lds, const Gemm g, const StaticOrder& S, const Epi& E, const int tid) {
    const int wid = __builtin_amdgcn_readfirstlane(tid >> 6), lane = tid & 63, wr = wid >> 2, wc = wid & 3, fr = lane & 15, fq = lane >> 4;
    int K = g.K; asm volatile("" : "+s"(K)); const int nt = K / BK;
    unsigned voffA[2], voffB[2];
#pragma unroll
    for (int i = 0; i < 2; ++i) { int R, C; stage_rc(tid * 16 + i * 8192, R, C); const int Rb = (R & ~31) + perm32(R & 31);
        voffA[i] = (unsigned)(R * g.lda + C) * 2u; voffB[i] = (unsigned)(Rb * g.ldb + C) * 2u; }
    const size_t kstep = (size_t)(BK * 2);
    const size_t hstepA = (size_t)HALF * g.lda * 2, hstepB = (size_t)HALF * g.ldb * 2;
    const size_t tstepA = 2 * hstepA, tstepB = 2 * hstepB;
    const unsigned ldsw = (unsigned)wid * 1024u;
    const int aoff = lds_byte(wr * 64 + fr, fq * 8), boff = lds_byte(wc * 32 + fr, fq * 8);
#define PG8_SA(b, h) (((b) * 2 + (h)) * HTB)
#define PG8_SB(b, h) ((4 + (b) * 2 + (h)) * HTB)
#define PG8_STAGE(bufoff, gbase, voff) do { _Pragma("unroll") for (int _i = 0; _i < 2; ++_i) \
        __builtin_amdgcn_global_load_lds((const unsigned*)((const char*)(gbase) + (voff)[_i]), (LAS unsigned*)(lds + (bufoff) + ldsw + _i * 8192), 16, 0, 0); } while (0)
#define PG8_LDA(dst, b, h) do { _Pragma("unroll") for (int m = 0; m < 4; ++m) _Pragma("unroll") for (int k = 0; k < 2; ++k) dst[m][k] = *(const LAS bf16x8*)(lds + PG8_SA(b, h) + aoff + m * 2048 + k * 1024); } while (0)
#define PG8_LDB(dst, b, h) do { _Pragma("unroll") for (int n = 0; n < 2; ++n) _Pragma("unroll") for (int k = 0; k < 2; ++k) dst[n][k] = *(const LAS bf16x8*)(lds + PG8_SB(b, h) + boff + n * 2048 + k * 1024); } while (0)
#define PG8_MMA(ai, bj, At, Bt) do { __builtin_amdgcn_s_setprio(1); _Pragma("unroll") for (int m = 0; m < 4; ++m) _Pragma("unroll") for (int n = 0; n < 2; ++n) _Pragma("unroll") for (int k = 0; k < 2; ++k) \
        acc[ai][bj][m][n] = __builtin_amdgcn_mfma_f32_16x16x32_bf16(Bt[n][k], At[m][k], acc[ai][bj][m][n], 0, 0, 0); __builtin_amdgcn_s_setprio(0); } while (0)
#define PG8_WAIT_V(n) asm volatile("s_waitcnt vmcnt(" #n ")" ::: "memory")
#define PG8_WAIT_L(n) asm volatile("s_waitcnt lgkmcnt(" #n ")" ::: "memory")
#define PG8_BAR __builtin_amdgcn_s_barrier()
#define PG8_SCHED __builtin_amdgcn_sched_barrier(0)
    Unit cur, nxt; int ui = 0;
    if (!S.next(0, cur)) return;
    f32x4 acc[2][2][4][2];
#pragma unroll
    for (int a = 0; a < 2; ++a)
#pragma unroll
        for (int b = 0; b < 2; ++b)
#pragma unroll
            for (int m = 0; m < 4; ++m)
#pragma unroll
                for (int n = 0; n < 2; ++n) acc[a][b][m][n] = (f32x4){0.f, 0.f, 0.f, 0.f};
    bf16x8 At[4][2], B0[2][2], B1[2][2];
    const char* cA = (const char*)g.A + (size_t)cur.pm * tstepA + (size_t)(cur.pn & g.amask) * g.astride; const char* cB = (const char*)g.Bt + (size_t)cur.pn * tstepB;
    PG8_STAGE(PG8_SB(0, 0), cB, voffB); PG8_STAGE(PG8_SB(0, 1), cB + hstepB, voffB); PG8_STAGE(PG8_SA(0, 0), cA, voffA); PG8_STAGE(PG8_SA(0, 1), cA + hstepA, voffA);
    if (wr == 1) PG8_BAR;
    PG8_WAIT_V(2); PG8_BAR;
    PG8_STAGE(PG8_SB(1, 0), cB + kstep, voffB); PG8_STAGE(PG8_SA(1, 0), cA + kstep, voffA); PG8_STAGE(PG8_SB(1, 1), cB + hstepB + kstep, voffB);
    PG8_WAIT_V(6); PG8_BAR;
    for (;;) {
        const bool has_next = S.next(ui + 1, nxt);
        const char* nA = has_next ? (const char*)g.A + (size_t)nxt.pm * tstepA + (size_t)(nxt.pn & g.amask) * g.astride : cA; const char* nB = has_next ? (const char*)g.Bt + (size_t)nxt.pn * tstepB : cB;
        for (int t = 0; t < nt; t += 2) {
            const bool last = (t == nt - 2);
            const char* a1 = cA + (size_t)(t + 1) * kstep;
            const char* a2 = last ? nA : cA + (size_t)(t + 2) * kstep; const char* b2 = last ? nB : cB + (size_t)(t + 2) * kstep;
            const char* a3 = a2 + kstep; const char* b3 = b2 + kstep;
            PG8_LDB(B0, 0, 0); PG8_LDB(B1, 0, 1); PG8_SCHED; PG8_LDA(At, 0, 0); PG8_STAGE(PG8_SA(1, 1), a1 + hstepA, voffA);
            PG8_WAIT_V(8); PG8_WAIT_L(0); PG8_BAR; PG8_MMA(0, 0, At, B0); PG8_MMA(0, 1, At, B1); PG8_BAR; PG8_SCHED;
            PG8_LDA(At, 0, 1); PG8_STAGE(PG8_SB(0, 0), b2, voffB); PG8_STAGE(PG8_SB(0, 1), b2 + hstepB, voffB); PG8_STAGE(PG8_SA(0, 0), a2, voffA);
            PG8_WAIT_V(8); PG8_WAIT_L(0); PG8_BAR; PG8_MMA(1, 0, At, B0); PG8_MMA(1, 1, At, B1); PG8_BAR; PG8_SCHED;
            PG8_LDB(B0, 1, 0); PG8_LDB(B1, 1, 1); PG8_SCHED; PG8_LDA(At, 1, 0); PG8_STAGE(PG8_SA(0, 1), a2 + hstepA, voffA);
            PG8_WAIT_V(8); PG8_WAIT_L(0); PG8_BAR; PG8_MMA(0, 0, At, B0); PG8_MMA(0, 1, At, B1); PG8_BAR; PG8_SCHED;
            PG8_LDA(At, 1, 1); PG8_STAGE(PG8_SB(1, 0), b3, voffB); PG8_STAGE(PG8_SB(1, 1), b3 + hstepB, voffB); PG8_STAGE(PG8_SA(1, 0), a3, voffA);
            PG8_WAIT_V(8); PG8_WAIT_L(0); PG8_BAR; PG8_MMA(1, 0, At, B0); PG8_MMA(1, 1, At, B1); PG8_BAR; PG8_SCHED;
        }
        if (wr == 0) PG8_BAR;
        E(acc, cur, wr, wc, fr, fq);
        if (!has_next) break;
#pragma unroll
        for (int a = 0; a < 2; ++a)
#pragma unroll
            for (int b = 0; b < 2; ++b)
#pragma unroll
                for (int m = 0; m < 4; ++m)
#pragma unroll
                    for (int n = 0; n < 2; ++n) acc[a][b][m][n] = (f32x4){0.f, 0.f, 0.f, 0.f};
        cur = nxt; cA = nA; cB = nB; ++ui;
        if (wr == 1) PG8_BAR;
    }
    PG8_WAIT_V(0);
    PG8_BAR;
#undef PG8_SA
#undef PG8_SB
#undef PG8_STAGE
#undef PG8_LDA
#undef PG8_LDB
#undef PG8_MMA
#undef PG8_WAIT_V
#undef PG8_WAIT_L
#undef PG8_BAR
#undef PG8_SCHED
}
}

namespace att {
constexpr int D = 128, NW = 8, QBLK = 32, KVBLK = 64;
constexpr float SCALE = 0.088388347648318440f;
constexpr float THR = 8.f;
constexpr int LDQ = QKVW, LDK = QKVW, LDO = DM;
constexpr size_t SHM_V = KVBLK * D * 2, SHM_K = KVBLK * D * 2, SHM_ATTN = 2 * SHM_V + 2 * SHM_K + NW * 64 * 4;
#define KSWZ(row, colB) ((row) * 256 + ((colB) ^ (((row) & 7) << 4)))
#define SBAR() __builtin_amdgcn_sched_barrier(0)
__device__ __forceinline__ int crow(int r, int hi) { return (r & 3) + 8 * (r >> 2) + 4 * hi; }
__device__ __forceinline__ void partialSM(f32x16& p0, f32x16& p1, float& m_reg, float& mn, float& alpha) {
  constexpr float C = SCALE * 1.4426950408889634f;
  float pmax = p0[0]; for (int r = 1; r < 16; ++r) pmax = fmaxf(pmax, p0[r]); for (int r = 0; r < 16; ++r) pmax = fmaxf(pmax, p1[r]);
  { auto rr = __builtin_amdgcn_permlane32_swap(__float_as_uint(pmax), __float_as_uint(pmax), false, false);
    pmax = fmaxf(__uint_as_float(rr[0]), __uint_as_float(rr[1])); }
  if (__builtin_expect(__all(pmax - m_reg <= THR / SCALE), 1)) { mn = m_reg; alpha = 1.f; }
  else { mn = fmaxf(m_reg, pmax); alpha = __builtin_amdgcn_exp2f((m_reg - mn) * C); m_reg = mn; }
  float mnC = -mn * C;
  for (int r = 0; r < 16; ++r) p0[r] = fmaf(p0[r], C, mnC); for (int r = 0; r < 16; ++r) p1[r] = fmaf(p1[r], C, mnC);
  for (int r = 0; r < 16; ++r) p0[r] = __builtin_amdgcn_exp2f(p0[r]);
}
__device__ __forceinline__ void finishSM(f32x16& p0, f32x16& p1, float alpha, float& l_reg, bf16x8& pa0, bf16x8& pa1, bf16x8& pa2, bf16x8& pa3) {
  for (int r = 0; r < 16; ++r) p1[r] = __builtin_amdgcn_exp2f(p1[r]);
  float ps = 0; for (int r = 0; r < 16; ++r) ps += p0[r]; for (int r = 0; r < 16; ++r) ps += p1[r];
  { auto rr = __builtin_amdgcn_permlane32_swap(__float_as_uint(ps), __float_as_uint(ps), false, false);
    ps = __uint_as_float(rr[0]) + __uint_as_float(rr[1]); }
  l_reg = l_reg * alpha + ps;
#define PK4(P, BASE, OUT) do { unsigned a0 = cvt_pk_bf16(P[BASE + 0], P[BASE + 1]), a1 = cvt_pk_bf16(P[BASE + 2], P[BASE + 3]);   \
    unsigned b0 = cvt_pk_bf16(P[BASE + 4], P[BASE + 5]), b1 = cvt_pk_bf16(P[BASE + 6], P[BASE + 7]);                              \
    auto r0 = __builtin_amdgcn_permlane32_swap(a0, b0, false, false); auto r1 = __builtin_amdgcn_permlane32_swap(a1, b1, false, false); \
    u32x4 w = {r0[0], r1[0], r0[1], r1[1]}; OUT = *reinterpret_cast<bf16x8*>(&w); } while (0)
  PK4(p0, 0, pa0); PK4(p0, 8, pa1); PK4(p1, 0, pa2); PK4(p1, 8, pa3);
#undef PK4
}
__device__ __forceinline__ void qkt(f32x16& p0, f32x16& p1, const bf16_t* Ks, const bf16x8* qr, int r32, int hi) {
  p0 = f32x16{}; p1 = f32x16{};
  for (int d0 = 0; d0 < 8; ++d0) { int cb = (d0 * 16 + hi * 8) * 2;
    bf16x8 b0 = *reinterpret_cast<const bf16x8*>((const char*)Ks + KSWZ(r32, cb));
    bf16x8 b1 = *reinterpret_cast<const bf16x8*>((const char*)Ks + KSWZ(32 + r32, cb));
    p0 = __builtin_amdgcn_mfma_f32_32x32x16_bf16(b0, qr[d0], p0, 0, 0, 0);
    p1 = __builtin_amdgcn_mfma_f32_32x32x16_bf16(b1, qr[d0], p1, 0, 0, 0); }
}
__device__ __forceinline__ int v_st(int k, int c) { const int kk = (k & ~0xC) | ((k & 4) << 1) | ((k & 8) >> 1); return ((kk >> 3) * 4 + (c >> 5)) * 512 + ((kk & 7) * 32 + (c & 31)) * 2; }
__device__ __forceinline__ int v_rd_base(int lane) { return ((lane & 3) << 3) | (((lane >> 2) & 3) << 6) | (((lane >> 4) & 1) << 5) | (((lane >> 5) & 1) << 8); }
constexpr int v_rd_off(int d0, int ks, int half) { return d0 * 512 + ks * 4096 + half * 2048; }
template <int OFF> __device__ __forceinline__ s16x4 tr_read(int vb) {
  s16x4 r; asm volatile("ds_read_b64_tr_b16 %0, %1 offset:%2" : "=&v"(r) : "v"(vb), "i"(OFF) : "memory"); return r;
}
template <int D0> __device__ __forceinline__ void pv_one(f32x16& od, int vb, bf16x8 pa0, bf16x8 pa1, bf16x8 pa2, bf16x8 pa3) {
  const s16x4 l0 = tr_read<v_rd_off(D0, 0, 0)>(vb), h0 = tr_read<v_rd_off(D0, 0, 1)>(vb), l1 = tr_read<v_rd_off(D0, 1, 0)>(vb), h1 = tr_read<v_rd_off(D0, 1, 1)>(vb);
  const s16x4 l2 = tr_read<v_rd_off(D0, 2, 0)>(vb), h2 = tr_read<v_rd_off(D0, 2, 1)>(vb), l3 = tr_read<v_rd_off(D0, 3, 0)>(vb), h3 = tr_read<v_rd_off(D0, 3, 1)>(vb);
  asm volatile("s_waitcnt lgkmcnt(0)" ::: "memory"); SBAR();
#define PK(L, H) (bf16x8){L[0], L[1], L[2], L[3], H[0], H[1], H[2], H[3]}
  od = __builtin_amdgcn_mfma_f32_32x32x16_bf16(pa0, PK(l0, h0), od, 0, 0, 0);
  od = __builtin_amdgcn_mfma_f32_32x32x16_bf16(pa1, PK(l1, h1), od, 0, 0, 0);
  od = __builtin_amdgcn_mfma_f32_32x32x16_bf16(pa2, PK(l2, h2), od, 0, 0, 0);
  od = __builtin_amdgcn_mfma_f32_32x32x16_bf16(pa3, PK(l3, h3), od, 0, 0, 0);
#undef PK
}
__device__ __forceinline__ void pv_d0(f32x16* o, int vb, bf16x8 pa0, bf16x8 pa1, bf16x8 pa2, bf16x8 pa3) {
  pv_one<0>(o[0], vb, pa0, pa1, pa2, pa3); pv_one<1>(o[1], vb, pa0, pa1, pa2, pa3); pv_one<2>(o[2], vb, pa0, pa1, pa2, pa3); pv_one<3>(o[3], vb, pa0, pa1, pa2, pa3);
}
__device__ __forceinline__ void glds16(unsigned voff, const void* sbase, unsigned lds_dst) {
  unsigned keep;
  asm volatile("s_mov_b32 %0, m0\n\ts_mov_b32 m0, %3\n\ts_nop 0\n\tglobal_load_lds_dwordx4 %1, %2\n\ts_mov_b32 m0, %0" : "=&s"(keep) : "v"(voff), "s"(sbase), "s"(lds_dst) : "memory");
}
#define WAIT_BAR(N) asm volatile("s_waitcnt vmcnt(" #N ") lgkmcnt(0)\n\ts_barrier" ::: "memory")
constexpr int SLOT = 16384, LK = 0, LV = 3 * SLOT, LWS = 6 * SLOT;
__device__ __forceinline__ void attn_dense_body(const bf16_t* __restrict__ Qb, const bf16_t* __restrict__ Kh, const bf16_t* __restrict__ Vh,
                                                bf16_t* __restrict__ Ob, int seq, char* lds, const int tid) {
  const int wid = __builtin_amdgcn_readfirstlane(tid >> 6), lane = tid & 63, r32 = lane & 31, hi = lane >> 5;
  const unsigned lds0 = (unsigned)(uintptr_t)lds;
  float* ws = (float*)(lds + LWS) + wid * 64; float* li_l = ws; float* al_l = ws + 32;
  float m_reg = -1e30f, l_reg = 0; f32x16 o[4] = {}; bf16x8 qr[8];
  const bf16_t* Qw = Qb + (long)(wid * QBLK + r32) * LDQ + hi * 8;
#pragma unroll
  for (int d0 = 0; d0 < 8; ++d0) qr[d0] = *reinterpret_cast<const bf16x8*>(Qw + d0 * 16);
  unsigned kof[2], vof[2];
#pragma unroll
  for (int i = 0; i < 2; ++i) { const int S = (i * 8 + wid) * 1024 + lane * 16;
    const int krow = S >> 8, kcolB = (S & 255) ^ ((krow & 7) << 4); kof[i] = (unsigned)(krow * (LDK * 2) + kcolB);
    const int sub = S >> 9, kk = (sub >> 2) * 8 + ((S & 511) >> 6), k = (kk & ~0xC) | ((kk & 4) << 1) | ((kk & 8) >> 1), c = (sub & 3) * 32 + ((S & 63) >> 1);
    vof[i] = (unsigned)(k * (LDK * 2) + c * 2); }
  const unsigned kdst = lds0 + LK + wid * 1024, vdst = lds0 + LV + wid * 1024;
  const int vb0 = (int)lds0 + LV + v_rd_base(lane);
#define DMA_K(t, so) do { const char* b_ = (const char*)Kh + (size_t)(t) * (KVBLK * LDK * 2); const unsigned d_ = (unsigned)__builtin_amdgcn_readfirstlane(kdst + (so)); glds16(kof[0], b_, d_); glds16(kof[1], b_, d_ + 8192u); } while (0)
#define DMA_V(t, so) do { const char* b_ = (const char*)Vh + (size_t)(t) * (KVBLK * LDK * 2); const unsigned d_ = (unsigned)__builtin_amdgcn_readfirstlane(vdst + (so)); glds16(vof[0], b_, d_); glds16(vof[1], b_, d_ + 8192u); } while (0)
#define RESC(a) do { if (__any((a) < 1.f)) { if (hi == 0) al_l[r32] = (a); asm volatile("s_waitcnt lgkmcnt(0)" ::: "memory"); \
    for (int d = 0; d < 4; ++d) for (int r = 0; r < 16; ++r) o[d][r] *= al_l[crow(r, hi)]; } } while (0)
#define KPTR(so) ((const bf16_t*)(lds + LK + (so)))
  f32x16 pA0, pA1, pB0, pB1; float mnA, mnB, alA, alB; bf16x8 pa0, pa1, pa2, pa3; const int NT = seq / KVBLK;
  DMA_K(0, 0); DMA_V(0, 0); DMA_K(1, SLOT);
  WAIT_BAR(0);
  DMA_K(2, 2 * SLOT); DMA_V(1, SLOT);
  qkt(pA0, pA1, KPTR(0), qr, r32, hi); partialSM(pA0, pA1, m_reg, mnA, alA);
  WAIT_BAR(4);
  int s0 = 0, s1 = SLOT, s2 = 2 * SLOT;
#define ROT() do { const int t_ = s0; s0 = s1; s1 = s2; s2 = t_; } while (0)
  for (int j = 1; j + 1 < NT; j += 2) {
    DMA_K(j + 2, s0); DMA_V(j + 1, s2);
    SBAR(); qkt(pB0, pB1, KPTR(s1), qr, r32, hi);
    finishSM(pA0, pA1, alA, l_reg, pa0, pa1, pa2, pa3); SBAR();
    pv_d0(o, vb0 + s0, pa0, pa1, pa2, pa3); partialSM(pB0, pB1, m_reg, mnB, alB);
    RESC(alB);
    WAIT_BAR(4); ROT();
    { const int tk = (j + 3 < NT) ? j + 3 : NT - 1; DMA_K(tk, s0); } DMA_V(j + 2, s2);
    SBAR(); qkt(pA0, pA1, KPTR(s1), qr, r32, hi);
    finishSM(pB0, pB1, alB, l_reg, pa0, pa1, pa2, pa3); SBAR();
    pv_d0(o, vb0 + s0, pa0, pa1, pa2, pa3); partialSM(pA0, pA1, m_reg, mnA, alA);
    RESC(alA);
    WAIT_BAR(4); ROT();
  }
  SBAR(); qkt(pB0, pB1, KPTR(s1), qr, r32, hi);
  finishSM(pA0, pA1, alA, l_reg, pa0, pa1, pa2, pa3); SBAR();
  pv_d0(o, vb0 + s0, pa0, pa1, pa2, pa3); partialSM(pB0, pB1, m_reg, mnB, alB);
  RESC(alB);
  WAIT_BAR(0);
  finishSM(pB0, pB1, alB, l_reg, pa0, pa1, pa2, pa3); SBAR();
  pv_d0(o, vb0 + s1, pa0, pa1, pa2, pa3);
  if (hi == 0) li_l[r32] = l_reg; asm volatile("s_waitcnt lgkmcnt(0)" ::: "memory");
  float rli[16];
#pragma unroll
  for (int r = 0; r < 16; ++r) rli[r] = __builtin_amdgcn_rcpf(li_l[crow(r, hi)]);
  WAIT_BAR(0);
  bf16_t* stg = (bf16_t*)lds + wid * 4096;
#pragma unroll
  for (int r = 0; r < 16; ++r) { const int orow = crow(r, hi);
#pragma unroll
    for (int d0 = 0; d0 < 4; ++d0) { const unsigned w = cvt_pk_bf16(o[d0][r] * rli[r], 0.f); stg[orow * 128 + d0 * 32 + r32] = (bf16_t)(w & 0xffffu); } }
  asm volatile("s_waitcnt lgkmcnt(0)" ::: "memory");
  bf16_t* Ow = Ob + (long)(wid * QBLK) * LDO;
#pragma unroll
  for (int i = 0; i < 8; ++i) { const int row = i * 4 + (lane >> 4), ch = lane & 15; const u32x4 v = *(const u32x4*)(stg + row * 128 + ch * 8); *(u32x4*)(Ow + (long)row * LDO + ch * 8) = v; }
  WAIT_BAR(0);
#undef DMA_K
#undef DMA_V
#undef RESC
#undef KPTR
#undef ROT
}
#undef WAIT_BAR

typedef int v8i __attribute__((ext_vector_type(8)));
typedef int v4i __attribute__((ext_vector_type(4)));
constexpr int SLOT8 = 8192, LK8 = 0, LV8 = 3 * SLOT8, LWS8 = 65536;
constexpr float THR8 = 3.f, POFF8 = 4.f;
#define KSW8(row, byte) ((row) * 128 + (((((byte) >> 4) ^ (((row) >> 1) & 7))) << 4) + ((byte) & 15))
#define VSW8(col, byte) ((col) * 64 + (((((byte) >> 4) ^ (((col) >> 2) & 3))) << 4) + ((byte) & 15))
__device__ __forceinline__ v8i cat8(v4i a, v4i b) { return (v8i){a[0], a[1], a[2], a[3], b[0], b[1], b[2], b[3]}; }
constexpr float THRL8 = THR8 * 1.4426950408889634f;
template <bool FIRST> __device__ __forceinline__ void partialSM8(f32x16& p0, f32x16& p1, float& m_ref, f32x16& negm, float& alpha) {
  float pmax = p0[0]; for (int r = 1; r < 16; ++r) pmax = fmaxf(pmax, p0[r]); for (int r = 0; r < 16; ++r) pmax = fmaxf(pmax, p1[r]);
  { auto rr = __builtin_amdgcn_permlane32_swap(__float_as_uint(pmax), __float_as_uint(pmax), false, false);
    pmax = fmaxf(__uint_as_float(rr[0]), __uint_as_float(rr[1])); }
  const float delta = pmax - POFF8;
  alpha = 1.f;
  if (FIRST || !__builtin_expect(__all(delta <= THRL8), 1)) {
    const float dl = FIRST ? delta : fmaxf(delta, 0.f);
    m_ref += dl;
    for (int r = 0; r < 16; ++r) { p0[r] -= dl; p1[r] -= dl; }
    const float nm = POFF8 - m_ref;
    for (int r = 0; r < 16; ++r) negm[r] = nm;
    if (!FIRST) alpha = __builtin_amdgcn_exp2f(-dl);
  }
  for (int r = 0; r < 16; ++r) p0[r] = __builtin_amdgcn_exp2f(p0[r]);
}
__device__ __forceinline__ void finishSM8(f32x16& p0, f32x16& p1, v8i& pa) {
  for (int r = 0; r < 16; ++r) p1[r] = __builtin_amdgcn_exp2f(p1[r]);
#pragma unroll
  for (int w = 0; w < 4; ++w) { int x = 0; x = __builtin_amdgcn_cvt_pk_fp8_f32(p0[4 * w], p0[4 * w + 1], x, false); x = __builtin_amdgcn_cvt_pk_fp8_f32(p0[4 * w + 2], p0[4 * w + 3], x, true); pa[w] = x; }
#pragma unroll
  for (int w = 0; w < 4; ++w) { int x = 0; x = __builtin_amdgcn_cvt_pk_fp8_f32(p1[4 * w], p1[4 * w + 1], x, false); x = __builtin_amdgcn_cvt_pk_fp8_f32(p1[4 * w + 2], p1[4 * w + 3], x, true); pa[4 + w] = x; }
}
__device__ __forceinline__ void qkt8(f32x16& p0, f32x16& p1, const char* Ks, const v8i* qr, const f32x16& negm, int r32, int hi) {
#pragma unroll
  for (int c = 0; c < 2; ++c) { const int b0 = 64 * c + 32 * hi;
    const v8i a0 = cat8(*reinterpret_cast<const v4i*>(Ks + KSW8(r32, b0)), *reinterpret_cast<const v4i*>(Ks + KSW8(r32, b0 + 16)));
    const v8i a1 = cat8(*reinterpret_cast<const v4i*>(Ks + KSW8(32 + r32, b0)), *reinterpret_cast<const v4i*>(Ks + KSW8(32 + r32, b0 + 16)));
    if (c == 0) { p0 = __builtin_amdgcn_mfma_scale_f32_32x32x64_f8f6f4(a0, qr[c], negm, 0, 0, 0, 0, 0, 0); p1 = __builtin_amdgcn_mfma_scale_f32_32x32x64_f8f6f4(a1, qr[c], negm, 0, 0, 0, 0, 0, 0); }
    else { p0 = __builtin_amdgcn_mfma_scale_f32_32x32x64_f8f6f4(a0, qr[c], p0, 0, 0, 0, 0, 0, 0); p1 = __builtin_amdgcn_mfma_scale_f32_32x32x64_f8f6f4(a1, qr[c], p1, 0, 0, 0, 0, 0, 0); } }
}
__device__ __forceinline__ void pv8(f32x16* o, const char* Vs, v8i pa, int r32, int hi) {
#pragma unroll
  for (int d0 = 0; d0 < 4; ++d0) { const int col = 32 * d0 + r32;
    const v8i b = cat8(*reinterpret_cast<const v4i*>(Vs + VSW8(col, 32 * hi)), *reinterpret_cast<const v4i*>(Vs + VSW8(col, 32 * hi + 16)));
    o[d0] = __builtin_amdgcn_mfma_scale_f32_32x32x64_f8f6f4(pa, b, o[d0], 0, 0, 0, 0, 0, 0); }
  const int one4 = 0x38383838;
  const v8i ones = (v8i){one4, one4, one4, one4, one4, one4, one4, one4};
  o[4] = __builtin_amdgcn_mfma_scale_f32_32x32x64_f8f6f4(pa, ones, o[4], 0, 0, 0, 0, 0, 0);
}
__device__ __forceinline__ void attn_fp8_body(const unsigned char* __restrict__ Q8w, const unsigned char* __restrict__ K8t, const unsigned char* __restrict__ V8t,
                                              bf16_t* __restrict__ Ob, int seq, char* lds, const int tid) {
  const int wid = __builtin_amdgcn_readfirstlane(tid >> 6), lane = tid & 63, r32 = lane & 31, hi = lane >> 5;
  const unsigned lds0 = (unsigned)(uintptr_t)lds;
  float* al_l = (float*)(lds + LWS8) + wid * 64;
  float m_ref = 0.f; f32x16 o[5] = {}; v8i qr[2]; f32x16 negm; for (int r = 0; r < 16; ++r) negm[r] = POFF8; asm volatile("" : "+v"(negm));
  { const unsigned char* qp = Q8w + (size_t)(wid * QBLK + r32) * 1024 + 32 * hi;
#pragma unroll
    for (int c = 0; c < 2; ++c) qr[c] = cat8(*reinterpret_cast<const v4i*>(qp + 64 * c), *reinterpret_cast<const v4i*>(qp + 64 * c + 16)); }
  unsigned kof, vof;
  { const int S = wid * 1024 + lane * 16;
    const int krow = S >> 7, kch = ((S >> 4) & 7) ^ ((krow >> 1) & 7); kof = (unsigned)(krow * 256 + kch * 16);
    const int vcol = S >> 6, vch = ((S >> 4) & 3) ^ ((vcol >> 2) & 3); vof = (unsigned)(vcol * 64 + vch * 16); }
  const unsigned kdst = lds0 + LK8 + wid * 1024, vdst = lds0 + LV8 + wid * 1024;
#define WAIT_BAR(N) asm volatile("s_waitcnt vmcnt(" #N ") lgkmcnt(0)\n\ts_barrier" ::: "memory")
#define DMA_K(t, so) do { const char* b_ = (const char*)K8t + (size_t)(t) * (KVBLK * 256); glds16(kof, b_, (unsigned)__builtin_amdgcn_readfirstlane(kdst + (so))); } while (0)
#define DMA_V(t, so) do { const char* b_ = (const char*)V8t + (size_t)(t) * 8192; glds16(vof, b_, (unsigned)__builtin_amdgcn_readfirstlane(vdst + (so))); } while (0)
#define RESC(a) do { if (__any((a) < 1.f)) { if (hi == 0) al_l[r32] = (a); asm volatile("s_waitcnt lgkmcnt(0)" ::: "memory"); \
    for (int d = 0; d < 5; ++d) for (int r = 0; r < 16; ++r) o[d][r] *= al_l[crow(r, hi)]; } } while (0)
#define KP8(so) ((const char*)(lds + LK8 + (so)))
#define VP8(so) ((const char*)(lds + LV8 + (so)))
  f32x16 pA0, pA1, pB0, pB1; float alA, alB; v8i pa; const int NT = seq / KVBLK;
  DMA_K(0, 0); DMA_V(0, 0); DMA_K(1, SLOT8);
  WAIT_BAR(0);
  DMA_K(2, 2 * SLOT8); DMA_V(1, SLOT8);
  qkt8(pA0, pA1, KP8(0), qr, negm, r32, hi); partialSM8<true>(pA0, pA1, m_ref, negm, alA);
  WAIT_BAR(2);
  int s0 = 0, s1 = SLOT8, s2 = 2 * SLOT8;
#define ROT() do { const int t_ = s0; s0 = s1; s1 = s2; s2 = t_; } while (0)
  for (int j = 1; j + 1 < NT; j += 2) {
    DMA_K(j + 2, s0); DMA_V(j + 1, s2);
    SBAR(); qkt8(pB0, pB1, KP8(s1), qr, negm, r32, hi);
    finishSM8(pA0, pA1, pa); SBAR();
    pv8(o, VP8(s0), pa, r32, hi); partialSM8<false>(pB0, pB1, m_ref, negm, alB);
    RESC(alB);
    WAIT_BAR(2); ROT();
    { const int tk = (j + 3 < NT) ? j + 3 : NT - 1; DMA_K(tk, s0); } DMA_V(j + 2, s2);
    SBAR(); qkt8(pA0, pA1, KP8(s1), qr, negm, r32, hi);
    finishSM8(pB0, pB1, pa); SBAR();
    pv8(o, VP8(s0), pa, r32, hi); partialSM8<false>(pA0, pA1, m_ref, negm, alA);
    RESC(alA);
    WAIT_BAR(2); ROT();
  }
  SBAR(); qkt8(pB0, pB1, KP8(s1), qr, negm, r32, hi);
  finishSM8(pA0, pA1, pa); SBAR();
  pv8(o, VP8(s0), pa, r32, hi); partialSM8<false>(pB0, pB1, m_ref, negm, alB);
  RESC(alB);
  WAIT_BAR(0);
  finishSM8(pB0, pB1, pa); SBAR();
  pv8(o, VP8(s1), pa, r32, hi);
  float rli[16];
#pragma unroll
  for (int r = 0; r < 16; ++r) rli[r] = __builtin_amdgcn_rcpf(o[4][r]);
  WAIT_BAR(0);
  bf16_t* stg = (bf16_t*)lds + wid * 4096;
#pragma unroll
  for (int r = 0; r < 16; ++r) { const int orow = crow(r, hi);
#pragma unroll
    for (int d0 = 0; d0 < 4; ++d0) { const unsigned w = cvt_pk_bf16(o[d0][r] * rli[r], 0.f); stg[orow * 128 + d0 * 32 + r32] = (bf16_t)(w & 0xffffu); } }
  asm volatile("s_waitcnt lgkmcnt(0)" ::: "memory");
  bf16_t* Ow = Ob + (long)(wid * QBLK) * LDO;
#pragma unroll
  for (int i = 0; i < 8; ++i) { const int row = i * 4 + (lane >> 4), ch = lane & 15; const u32x4 v = *(const u32x4*)(stg + row * 128 + ch * 8); *(u32x4*)(Ow + (long)row * LDO + ch * 8) = v; }
  WAIT_BAR(0);
#undef WAIT_BAR
#undef DMA_K
#undef DMA_V
#undef RESC
#undef KP8
#undef VP8
#undef ROT
}
#undef KSWZ
#undef SBAR
}

#define XB_TMO      128
#define XB_XCNT(j)  (256  + 64 * (j))
#define XB_XSUB(j)  (1280 + 64 * (j))
#define XB_XGEN(j)  (2304 + 64 * (j))
#define XB_TOP      3328
#define XB_TOPGEN   3392
#define XCD_BAR_WORDS 3456
#define XB_SPIN_CAP (1u << 18)

__device__ __forceinline__ unsigned xb_ld(unsigned* p)              { return __hip_atomic_load(p, __ATOMIC_RELAXED, __HIP_MEMORY_SCOPE_AGENT); }
__device__ __forceinline__ unsigned xb_add(unsigned* p, unsigned v) { return __hip_atomic_fetch_add(p, v, __ATOMIC_RELAXED, __HIP_MEMORY_SCOPE_AGENT); }
__device__ __forceinline__ unsigned xb_xcc_id() { return (unsigned)__builtin_amdgcn_s_getreg((3 << 11) | 20) & 0xFu; }
#define XB_SPIN(cond, bar) do { unsigned _sp = 0; while (cond) { __builtin_amdgcn_s_sleep(1); \
    if ((++_sp & 255u) == 0u) { if (xb_ld(&(bar)[XB_TMO])) break; if (_sp > XB_SPIN_CAP) { atomicAdd(&(bar)[XB_TMO], 1u); break; } } } } while (0)

struct XcdBarrier {
    unsigned* bar; unsigned x;
    volatile LAS unsigned* st;
};

__device__ __forceinline__ XcdBarrier xcd_barrier_post(unsigned* bar, volatile LAS unsigned* st) {
    XcdBarrier b; b.bar = bar; b.x = xb_xcc_id(); b.st = st;
    if (threadIdx.x == 0) (void)xb_add(&bar[XB_XCNT(b.x)], 1u);
    return b;
}
__device__ __forceinline__ void xcd_barrier_complete(unsigned* bar, unsigned x, unsigned& nloc, unsigned& nx) {
    const unsigned G = gridDim.x * gridDim.y * gridDim.z;
    unsigned sum, cnt, mine, sp = 0u;
    for (;;) {
        sum = 0u; cnt = 0u; mine = 0u;
#pragma unroll
        for (unsigned j = 0; j < 16; ++j) { const unsigned c = xb_ld(&bar[XB_XCNT(j)]); sum += c; cnt += (c > 0u) ? 1u : 0u; mine = (j == x) ? c : mine; }
        if (sum == G) break;
        __builtin_amdgcn_s_sleep(1);
        if ((++sp & 255u) == 0u) { if (xb_ld(&bar[XB_TMO])) break; if (sp > XB_SPIN_CAP) { atomicAdd(&bar[XB_TMO], 1u); break; } }
    }
    nloc = mine > 0u ? mine : 1u; nx = cnt > 0u ? cnt : 1u;
}

__device__ __forceinline__ void xcd_barrier(const XcdBarrier& b) {
    asm volatile("s_waitcnt vmcnt(0)" ::: "memory");
    __syncthreads();
    if (threadIdx.x == 0) {
        unsigned* bar = b.bar;
        __builtin_amdgcn_s_waitcnt(0);
        unsigned nloc = b.st[0], nx = b.st[1];
        if (nloc == 0u) { xcd_barrier_complete(bar, b.x, nloc, nx); b.st[0] = nloc; b.st[1] = nx; }
        const unsigned old = xb_add(&bar[XB_XSUB(b.x)], 1u);
        const unsigned gen = old / nloc;
        if (old + 1u == (gen + 1u) * nloc) {
            __builtin_amdgcn_fence(__ATOMIC_RELEASE, "agent");
            asm volatile("s_waitcnt vmcnt(0)" ::: "memory");
            const unsigned og = xb_add(&bar[XB_TOP], 1u);
            const unsigned tg = og / nx;
            if (og + 1u == (tg + 1u) * nx) xb_add(&bar[XB_TOPGEN], 1u);
            else XB_SPIN(xb_ld(&bar[XB_TOPGEN]) == tg, bar);
            __builtin_amdgcn_fence(__ATOMIC_ACQUIRE, "agent");
            xb_add(&bar[XB_XGEN(b.x)], 1u);
            asm volatile("s_waitcnt vmcnt(0)" ::: "memory");
        } else {
            XB_SPIN(xb_ld(&bar[XB_XGEN(b.x)]) == gen, bar);
            __builtin_amdgcn_fence(__ATOMIC_ACQUIRE, "agent");
            asm volatile("s_waitcnt vmcnt(0)" ::: "memory");
        }
    }
    __syncthreads();
}


constexpr int NPH = 15;
constexpr unsigned GEMM_MASK = (1u << 1) | (1u << 2) | (1u << 3) | (1u << 5) | (1u << 9) | (1u << 10) | (1u << 11) | (1u << 12) | (1u << 13), ALL_MASK = 0x7FFFu;
constexpr unsigned MK_SW = (1u << 1) | (1u << 11), MK_RES = (1u << 2) | (1u << 9) | (1u << 12);
constexpr int LDS_BYTES = 147456;
struct Params { const float* in[26]; float* out; unsigned char* ws; int nprog, pad; unsigned char prog[32]; };

__device__ __forceinline__ void transpose_item(const float* W, int K, int N, const float* gain, bf16_t* WT, int blk, int mul, int add, LAS float* scr, int item, int lane) {
    const int nblk = N / 32, kb = item / nblk, nb = item % nblk, k0 = 64 * kb, n0 = 32 * nb;
    const int drow = (n0 / blk) * mul + add + (n0 % blk);
    float wv[32];
#pragma unroll
    for (int i = 0; i < 32; ++i) wv[i] = W[(size_t)(k0 + 2 * i + (lane >> 5)) * N + n0 + (lane & 31)];
    if (gain) {
#pragma unroll
        for (int i = 0; i < 32; ++i) wv[i] *= gain[k0 + 2 * i + (lane >> 5)];
    }
#pragma unroll
    for (int i = 0; i < 32; ++i) scr[(2 * i + (lane >> 5)) * 33 + (lane & 31)] = wv[i];
    asm volatile("s_waitcnt lgkmcnt(0)" ::: "memory");
    const int c = lane & 7;
#pragma unroll
    for (int j = 0; j < 4; ++j) { const int n = (lane >> 3) + 8 * j; const LAS float* s = scr + (8 * c) * 33 + n;
        u32x4 o; o.x = cvt_pk_bf16(s[0 * 33], s[1 * 33]); o.y = cvt_pk_bf16(s[2 * 33], s[3 * 33]); o.z = cvt_pk_bf16(s[4 * 33], s[5 * 33]); o.w = cvt_pk_bf16(s[6 * 33], s[7 * 33]);
        *(u32x4*)(WT + (size_t)(drow + n) * K + k0 + 8 * c) = o; }
    asm volatile("s_waitcnt lgkmcnt(0)" ::: "memory");
}

template <unsigned MASK> __global__ void __launch_bounds__(512, 2) mega(Params P) {
#define HAS(k) ((MASK >> (k)) & 1u)
    extern __shared__ __attribute__((aligned(16))) unsigned char lds_raw[];
    LAS unsigned char* lds = (LAS unsigned char*)lds_raw;
    cg::grid_group grid = cg::this_grid();
    const int G = gridDim.x, bx = blockIdx.x;
    const int wave0 = __builtin_amdgcn_readfirstlane((int)threadIdx.x >> 6);
    const int vcu = (G % 8 == 0) ? (bx % 8) * (G / 8) + bx / 8 : bx;
    typedef __attribute__((address_space(4))) const Params CParams;
    CParams* const pk = (CParams*)__builtin_amdgcn_kernarg_segment_ptr();
#define SS ((float*)(ws + WS_SS))
#define ROPE ((float*)(ws + WS_ROPE))
#define AGGA ((float*)(ws + WS_AGGA))
#define AGGH ((float*)(ws + WS_AGGH))
#define XB ((bf16_t*)(ws + WS_XB))
#define X ((float*)(ws + WS_X))
#define H ((bf16_t*)(ws + WS_H))
#define RA ((bf16_t*)(ws + WS_RA))
#define BXb ((bf16_t*)(ws + WS_BX))
#define QKV ((bf16_t*)(ws + WS_QKV))
#define PB ((bf16_t*)(ws + WS_PB))
#define U ((bf16_t*)(dob + DO_U))
#define UC ((bf16_t*)(dob + DO_UC))
#define GY ((bf16_t*)(dob + DO_GY))
#define MIX ((bf16_t*)(dob + DO_MIX))
#define PP ((bf16_t*)(dob + DO_PP))

    volatile LAS unsigned* bst = (volatile LAS unsigned*)(lds + 131072 + 512);
    if (threadIdx.x < 2) bst[threadIdx.x] = 0u;
    __syncthreads();
    const XcdBarrier xbar = xcd_barrier_post((unsigned*)(P.ws + WS_BAR), bst);
    const int nprog = P.nprog;
    for (int pi = 0; pi < nprog; ++pi) {
        CParams* pp = pk; asm volatile("" : "+s"(pp));
        unsigned char* const ws = pp->ws; unsigned char* const dob = (unsigned char*)pp->out;
        const int ph = pp->prog[pi];
        int wv_ = wave0; asm volatile("" : "+s"(wv_));
        int tid = wv_ * 64 + (int)__builtin_amdgcn_mbcnt_hi(~0u, __builtin_amdgcn_mbcnt_lo(~0u, 0u)); asm volatile("" : "+v"(tid));
#define THREAD_IDS() const int lane = tid & 63, wave = __builtin_amdgcn_readfirstlane(tid >> 6); const long gt = (long)vcu * 512 + tid, NT_ = (long)G * 512; const int gw = vcu * 8 + wave, NGW = G * 8; (void)lane; (void)gt; (void)NT_; (void)gw; (void)NGW
        if (HAS(0) && ph == 0) {
            THREAD_IDS();
            for (long i = gt; i < 4L * T; i += NT_) SS[i] = 0.f;
            for (long i = gt; i < 320 * 32; i += NT_) {
                const int pos = (int)(i >> 5), j = (int)(i & 31);
                const float inv = exp2f(-(float)j * 0.41524101186092029f);
                const float ang = (float)(pos < 256 ? pos : pos - 256) * inv;
                double rev = (double)ang * 0.15915494309189535; rev -= floor(rev);
                const float fr = (float)rev;
                ROPE[i] = __builtin_amdgcn_cosf(fr); ROPE[320 * 32 + i] = __builtin_amdgcn_sinf(fr);
            }
            for (long i = gt; i < 2 * LRUW; i += NT_) { const float nl = -pp->in[16][i]; ((float*)(ws + WS_C8))[i] = -8.0f * (fmaxf(nl, 0.f) + log1pf(__expf(-fabsf(nl)))) * 1.4426950408889634f; }
            { const float* p = pp->in[1];
              for (long i = gt; i < (long)T * PLED / 8; i += NT_) { const f32x4 a = *(const f32x4*)(p + i * 8), b = *(const f32x4*)(p + i * 8 + 4);
                  u32x4 w; w.x = cvt_pk_bf16(a[0], a[1]); w.y = cvt_pk_bf16(a[2], a[3]); w.z = cvt_pk_bf16(b[0], b[1]); w.w = cvt_pk_bf16(b[2], b[3]); *(u32x4*)(PB + i * 8) = w; } }
            { const float* x = pp->in[0]; const float* g1 = pp->in[2];
              for (int m = gw; m < T; m += NGW) {
                  const f32x4* xr = (const f32x4*)(x + (size_t)m * DM) + lane;
                  f32x4 v[8]; float s = 0.f;
#pragma unroll
                  for (int j = 0; j < 8; ++j) { v[j] = xr[64 * j]; s += (v[j][0] * v[j][0] + v[j][1] * v[j][1]) + (v[j][2] * v[j][2] + v[j][3] * v[j][3]); }
                  const float rs = __builtin_amdgcn_rsqf(wave_sum(s) * (1.0f / DM) + EPS);
                  u32x2* o8 = (u32x2*)(XB + (size_t)m * DM) + lane;
#pragma unroll
                  for (int j = 0; j < 8; ++j) { const f32x4 gg = *((const f32x4*)g1 + lane + 64 * j); u32x2 w; w.x = cvt_pk_bf16(v[j][0] * rs * gg[0], v[j][1] * rs * gg[1]); w.y = cvt_pk_bf16(v[j][2] * rs * gg[2], v[j][3] * rs * gg[3]); o8[64 * j] = w; }
              } }
            { LAS float* scr = (LAS float*)(lds + wave * 16384);
              constexpr int I_FF = (DM / 64) * (DFF / 32), I_IN = (DM / 64) * (INC / 32), I_SQ = (DM / 64) * (DM / 32), I_WP = (PLED / 64) * (DM / 32), I_L = 32 * 8;
              constexpr int NITEMS = 6 * I_FF + I_IN + 2 * I_SQ + I_WP + I_L;
              for (int it = gw; it < NITEMS; it += NGW) {
                  int r = it;
                  if (r < I_FF) { transpose_item(pp->in[3], DM, DFF, nullptr, (bf16_t*)(ws + WS_W13_1), 128, 256, 0, scr, r, lane); continue; } r -= I_FF;
                  if (r < I_FF) { transpose_item(pp->in[4], DM, DFF, nullptr, (bf16_t*)(ws + WS_W13_1), 128, 256, 128, scr, r, lane); continue; } r -= I_FF;
                  if (r < I_FF) { transpose_item(pp->in[5], DFF, DM, nullptr, (bf16_t*)(ws + WS_W2_1), DM, 0, 0, scr, r, lane); continue; } r -= I_FF;
                  if (r < I_FF) { transpose_item(pp->in[19], DM, DFF, pp->in[18], (bf16_t*)(ws + WS_W13_2), 128, 256, 0, scr, r, lane); continue; } r -= I_FF;
                  if (r < I_FF) { transpose_item(pp->in[20], DM, DFF, pp->in[18], (bf16_t*)(ws + WS_W13_2), 128, 256, 128, scr, r, lane); continue; } r -= I_FF;
                  if (r < I_FF) { transpose_item(pp->in[21], DFF, DM, nullptr, (bf16_t*)(ws + WS_W2_2), DM, 0, 0, scr, r, lane); continue; } r -= I_FF;
                  if (r < I_IN) { transpose_item(pp->in[7], DM, INC, pp->in[6], (bf16_t*)(ws + WS_WIN), INC, 0, 0, scr, r, lane); continue; } r -= I_IN;
                  if (r < I_SQ) { transpose_item(pp->in[17], DM, DM, nullptr, (bf16_t*)(ws + WS_WOUT), DM, 0, 0, scr, r, lane); continue; } r -= I_SQ;
                  if (r < I_SQ) { transpose_item(pp->in[23], DM, DM, pp->in[22], (bf16_t*)(ws + WS_WG), DM, 0, 0, scr, r, lane); continue; } r -= I_SQ;
                  if (r < I_WP) { transpose_item(pp->in[24], PLED, DM, nullptr, (bf16_t*)(ws + WS_WP), DM, 0, 0, scr, r, lane); continue; } r -= I_WP;
                  { const int mat = r >> 3, which = mat >> 4, dh = mat & 15;
                    transpose_item((which ? pp->in[14] : pp->in[12]) + (size_t)dh * 128 * 128, 128, 128, nullptr, (bf16_t*)(ws + WS_WL), 128, 0, dh * 256 + which * 128, scr, r & 7, lane); }
              } }
            __syncthreads();
        } else if (HAS(4) && ph == 4) {
            THREAD_IDS();
            { const float* qn = pp->in[8]; const float* kn = pp->in[9];
#define QK_LOAD(I_) (((I_) < (long)T * 160) ? *(const u32x4*)(QKV + (size_t)(((I_) >> 4) / 10) * QKVW + (int)(((I_) >> 4) % 10) * 128 + (int)((I_) & 15) * 8) : (u32x4){0u, 0u, 0u, 0u})
#define QK_TASK(W_, I_) do { const long i = (I_); if (i < (long)T * 160) { \
                  const int sub = (int)(i & 15); const long th = i >> 4; const int hh = (int)(th % 10); const int t = (int)(th / 10); \
                  const u32x4 w = (W_); \
                  const float v0 = bf_lo(w.x), v1 = bf_hi(w.x), v2 = bf_lo(w.y), v3 = bf_hi(w.y), v4 = bf_lo(w.z), v5 = bf_hi(w.z), v6 = bf_lo(w.w), v7 = bf_hi(w.w); \
                  float s = (v0 * v0 + v1 * v1) + (v2 * v2 + v3 * v3) + (v4 * v4 + v5 * v5) + (v6 * v6 + v7 * v7); \
                  s += __shfl_xor(s, 1); s += __shfl_xor(s, 2); s += __shfl_xor(s, 4); s += __shfl_xor(s, 8); \
                  float rs = __builtin_amdgcn_rsqf(s * (1.0f / 128.0f) + EPS); if (hh < 8) rs *= 0.12751743074602467f;   \
                  const float* gn = (hh < 8 ? qn : kn) + sub * 8; \
                  const int sp = t & (SEQ - 1); const int pos = (sub < 8) ? (sp >> 6) : 256 + (sp & 63); \
                  const float* ct = ROPE + pos * 32 + (sub & 7) * 4; const float* st = ct + 320 * 32; \
                  const f32x4 g0 = *(const f32x4*)gn, g1 = *(const f32x4*)(gn + 4), cc = *(const f32x4*)ct, ss = *(const f32x4*)st; \
                  const float a0 = v0 * rs * g0[0], b0 = v1 * rs * g0[1], a1 = v2 * rs * g0[2], b1 = v3 * rs * g0[3], a2 = v4 * rs * g1[0], b2 = v5 * rs * g1[1], a3 = v6 * rs * g1[2], b3 = v7 * rs * g1[3]; \
                  int w0 = 0, w1 = 0; \
                  w0 = __builtin_amdgcn_cvt_pk_fp8_f32(a0 * cc[0] - b0 * ss[0], a0 * ss[0] + b0 * cc[0], w0, false); w0 = __builtin_amdgcn_cvt_pk_fp8_f32(a1 * cc[1] - b1 * ss[1], a1 * ss[1] + b1 * cc[1], w0, true); \
                  w1 = __builtin_amdgcn_cvt_pk_fp8_f32(a2 * cc[2] - b2 * ss[2], a2 * ss[2] + b2 * cc[2], w1, false); w1 = __builtin_amdgcn_cvt_pk_fp8_f32(a3 * cc[3] - b3 * ss[3], a3 * ss[3] + b3 * cc[3], w1, true); \
                  unsigned char* dst8 = (hh < 8) ? (dob + DO_Q8 + (size_t)t * 1024 + hh * 128 + sub * 8) : (dob + DO_K8 + (size_t)t * 256 + (hh - 8) * 128 + sub * 8); \
                  *(u32x2*)dst8 = (u32x2){(unsigned)w0, (unsigned)w1}; } } while (0)
              for (long i0_ = gt; i0_ < (long)T * 160; i0_ += 4 * NT_) {
                  const u32x4 wq0 = QK_LOAD(i0_), wq1 = QK_LOAD(i0_ + NT_), wq2 = QK_LOAD(i0_ + 2 * NT_), wq3 = QK_LOAD(i0_ + 3 * NT_);
                  QK_TASK(wq0, i0_); QK_TASK(wq1, i0_ + NT_); QK_TASK(wq2, i0_ + 2 * NT_); QK_TASK(wq3, i0_ + 3 * NT_);
              } }
#undef QK_LOAD
#undef QK_TASK
            for (long i = gt; i < 262144; i += NT_) {
                const int n = (int)(i & 127), h = (int)((i >> 7) & 1), kvh = (int)((i >> 8) & 1), tile = (int)(i >> 9);
                const bf16_t* src = QKV + (size_t)tile * 64 * QKVW + 1280 + kvh * 128 + n;
                int wv8[8];
#pragma unroll
                for (int w = 0; w < 8; ++w) { float f[4];
#pragma unroll
                    for (int e = 0; e < 4; ++e) { const int sI = 4 * w + e; const int key = ((sI & 3) + 8 * ((sI & 15) >> 2) + 4 * h) + 32 * (sI >> 4); f[e] = __uint_as_float((unsigned)src[(size_t)key * QKVW] << 16); }
                    int x = 0; x = __builtin_amdgcn_cvt_pk_fp8_f32(f[0], f[1], x, false); x = __builtin_amdgcn_cvt_pk_fp8_f32(f[2], f[3], x, true); wv8[w] = x; }
                unsigned char* dv = dob + DO_V8 + ((size_t)((tile >> 8) * 2 + kvh) * 256 + (tile & 255)) * 8192 + n * 64 + h * 32;
                *(u32x4*)dv = (u32x4){(unsigned)wv8[0], (unsigned)wv8[1], (unsigned)wv8[2], (unsigned)wv8[3]};
                *(u32x4*)(dv + 16) = (u32x4){(unsigned)wv8[4], (unsigned)wv8[5], (unsigned)wv8[6], (unsigned)wv8[7]};
            }
            { const float* cw = pp->in[10]; const float* cb = pp->in[11];
#define CV_LOAD(I_, J_) ((((I_) < (long)T * 128) && ((int)(((I_) >> 7) & (SEQ - 1)) - 2 + (J_) >= 0) && ((int)(((I_) >> 7) & (SEQ - 1)) - 2 + (J_) < SEQ)) ? *(const u32x4*)(U + (size_t)((int)((I_) >> 7) - 2 + (J_)) * LRUW + (int)((I_) & 127) * 8) : (u32x4){0u, 0u, 0u, 0u})
#define CV_TAP(W_, J_) do { const u32x4 w = (W_); const f32x4 c0 = *(const f32x4*)(cw + (J_) * LRUW + c8), c1 = *(const f32x4*)(cw + (J_) * LRUW + c8 + 4); \
                  o0[0] += bf_lo(w.x) * c0[0]; o0[1] += bf_hi(w.x) * c0[1]; o0[2] += bf_lo(w.y) * c0[2]; o0[3] += bf_hi(w.y) * c0[3]; o1[0] += bf_lo(w.z) * c1[0]; o1[1] += bf_hi(w.z) * c1[1]; o1[2] += bf_lo(w.w) * c1[2]; o1[3] += bf_hi(w.w) * c1[3]; } while (0)
#define CV_TASK(I_, W0_, W1_, W2_, W3_) do { const long i = (I_); if (i < (long)T * 128) { const int c8 = (int)(i & 127) * 8; const int t = (int)(i >> 7); \
                  f32x4 o0 = *(const f32x4*)(cb + c8), o1 = *(const f32x4*)(cb + c8 + 4); \
                  CV_TAP(W0_, 0); CV_TAP(W1_, 1); CV_TAP(W2_, 2); CV_TAP(W3_, 3); \
                  u32x4 ow; ow.x = cvt_pk_bf16(o0[0], o0[1]); ow.y = cvt_pk_bf16(o0[2], o0[3]); ow.z = cvt_pk_bf16(o1[0], o1[1]); ow.w = cvt_pk_bf16(o1[2], o1[3]); \
                  *(u32x4*)(UC + (size_t)t * LRUW + c8) = ow; } } while (0)
              for (long i0_ = gt; i0_ < (long)T * 128; i0_ += 2 * NT_) {
                  const long i1_ = i0_ + NT_;
                  const u32x4 a0 = CV_LOAD(i0_, 0), a1 = CV_LOAD(i0_, 1), a2 = CV_LOAD(i0_, 2), a3 = CV_LOAD(i0_, 3), b0 = CV_LOAD(i1_, 0), b1 = CV_LOAD(i1_, 1), b2 = CV_LOAD(i1_, 2), b3 = CV_LOAD(i1_, 3);
                  CV_TASK(i0_, a0, a1, a2, a3); CV_TASK(i1_, b0, b1, b2, b3);
              } }
#undef CV_LOAD
#undef CV_TAP
#undef CV_TASK
        } else if (HAS(6) && ph == 6) {
            THREAD_IDS();
            const float* lam = (const float*)(ws + WS_C8);
            for (long i = gt; i < 2L * 2 * NCH * 512; i += NT_) {
                const int cp = (int)(i & 511); const int chunk = (int)((i >> 9) & (NCH - 1)); const int dir = (int)((i >> 16) & 1); const int b = (int)(i >> 17);
                const float k0 = lam[dir * LRUW + 2 * cp], k1 = lam[dir * LRUW + 2 * cp + 1];
                float A0 = 1.f, A1 = 1.f, H0 = 0.f, H1 = 0.f;
                const size_t base = ((size_t)dir * T + (size_t)b * SEQ + (size_t)chunk * CL) * LRUW + 2 * cp;
#pragma unroll 8
                for (int k = 0; k < CL; ++k) { const int tt = dir ? (CL - 1 - k) : k;
                    const unsigned rw = *(const unsigned*)(RA + base + (size_t)tt * LRUW), bw = *(const unsigned*)(BXb + base + (size_t)tt * LRUW);
                    const float a0 = __builtin_amdgcn_exp2f(k0 * bf_lo(rw)), a1 = __builtin_amdgcn_exp2f(k1 * bf_hi(rw));
                    H0 = a0 * H0 + bf_lo(bw); H1 = a1 * H1 + bf_hi(bw); A0 *= a0; A1 *= a1; }
                const size_t ao = (((size_t)b * 2 + dir) * NCH + chunk) * LRUW + 2 * cp;
                *(f32x2*)(AGGA + ao) = (f32x2){A0, A1}; *(f32x2*)(AGGH + ao) = (f32x2){H0, H1};
            }
        } else if (HAS(7) && ph == 7) {
            int seq_ = SEQ; asm volatile("" : "+s"(seq_));
            for (int u = vcu; u < 1024; u += G) {
                const int bkv = u >> 8, rem = u & 255, b = bkv >> 1, kvh = bkv & 1, gq = rem & 3, qb = rem >> 2, h = kvh * 4 + gq;
                const size_t rowb = (size_t)b * SEQ;
                att::attn_fp8_body(dob + DO_Q8 + (rowb + (size_t)qb * 256) * 1024 + h * 128, dob + DO_K8 + rowb * 256 + kvh * 128, dob + DO_V8 + (size_t)(b * 2 + kvh) * 256 * 8192,
                                   MIX + (rowb + (size_t)qb * 256) * DM + h * 128, seq_, (char*)lds_raw, tid);
            }
        } else if (HAS(8) && ph == 8) {
            THREAD_IDS();
            const float* lam = (const float*)(ws + WS_C8);
            for (long i = gt; i < 2L * NCH * 512; i += NT_) {
                const int cp = (int)(i & 511); const int chunk = (int)((i >> 9) & (NCH - 1)); const int b = (int)(i >> 16);
                float kf0, kf1, kb0, kb1;
                kf0 = lam[2 * cp]; kf1 = lam[2 * cp + 1]; kb0 = lam[LRUW + 2 * cp]; kb1 = lam[LRUW + 2 * cp + 1];
                float hf0 = 0.f, hf1 = 0.f, hb0 = 0.f, hb1 = 0.f;
#pragma unroll 8
                for (int j = 0; j < chunk; ++j) { const size_t ao = (((size_t)b * 2 + 0) * NCH + j) * LRUW + 2 * cp; const f32x2 a = *(const f32x2*)(AGGA + ao), hh = *(const f32x2*)(AGGH + ao); hf0 = a[0] * hf0 + hh[0]; hf1 = a[1] * hf1 + hh[1]; }
#pragma unroll 8
                for (int j = NCH - 1; j > chunk; --j) { const size_t ao = (((size_t)b * 2 + 1) * NCH + j) * LRUW + 2 * cp; const f32x2 a = *(const f32x2*)(AGGA + ao), hh = *(const f32x2*)(AGGH + ao); hb0 = a[0] * hb0 + hh[0]; hb1 = a[1] * hb1 + hh[1]; }
                const size_t row0 = (size_t)b * SEQ + (size_t)chunk * CL;
                const size_t fbase = row0 * LRUW + 2 * cp, bbase = ((size_t)T + row0) * LRUW + 2 * cp;
                bf16_t* mx = MIX + row0 * DM + 1024 + 2 * cp;
                {
                    unsigned rwc[8], bwc[8], rwn[8], bwn[8];
#pragma unroll
                    for (int u = 0; u < 8; ++u) { rwc[u] = *(const unsigned*)(RA + fbase + (size_t)u * LRUW); bwc[u] = *(const unsigned*)(BXb + fbase + (size_t)u * LRUW); }
                    for (int k0 = 0; k0 < CL; k0 += 8) {
                        const int kn = (k0 + 8 < CL) ? k0 + 8 : k0;
#pragma unroll
                        for (int u = 0; u < 8; ++u) { rwn[u] = *(const unsigned*)(RA + fbase + (size_t)(kn + u) * LRUW); bwn[u] = *(const unsigned*)(BXb + fbase + (size_t)(kn + u) * LRUW); }
#pragma unroll
                        for (int u = 0; u < 8; ++u) {
                            hf0 = __builtin_amdgcn_exp2f(kf0 * bf_lo(rwc[u])) * hf0 + bf_lo(bwc[u]); hf1 = __builtin_amdgcn_exp2f(kf1 * bf_hi(rwc[u])) * hf1 + bf_hi(bwc[u]);
                            *(unsigned*)(mx + (size_t)(k0 + u) * DM) = cvt_pk_bf16(hf0, hf1); }
#pragma unroll
                        for (int u = 0; u < 8; ++u) { rwc[u] = rwn[u]; bwc[u] = bwn[u]; }
                    }
                }
                asm volatile("s_waitcnt vmcnt(0)" ::: "memory");
                {
                    unsigned rwc[8], bwc[8], fwc[8], gwc[8], rwn[8], bwn[8], fwn[8], gwn[8];
#pragma unroll
                    for (int u = 0; u < 8; ++u) { const int k = CL - 1 - u; rwc[u] = *(const unsigned*)(RA + bbase + (size_t)k * LRUW); bwc[u] = *(const unsigned*)(BXb + bbase + (size_t)k * LRUW);
                        fwc[u] = *(const unsigned*)(mx + (size_t)k * DM); gwc[u] = *(const unsigned*)(GY + (row0 + k) * LRUW + 2 * cp); }
                    for (int k0 = CL - 1; k0 >= 0; k0 -= 8) {
                        const int kn = (k0 - 8 >= 0) ? k0 - 8 : k0;
#pragma unroll
                        for (int u = 0; u < 8; ++u) { const int k = kn - u; rwn[u] = *(const unsigned*)(RA + bbase + (size_t)k * LRUW); bwn[u] = *(const unsigned*)(BXb + bbase + (size_t)k * LRUW);
                            fwn[u] = *(const unsigned*)(mx + (size_t)k * DM); gwn[u] = *(const unsigned*)(GY + (row0 + k) * LRUW + 2 * cp); }
#pragma unroll
                        for (int u = 0; u < 8; ++u) { const int k = k0 - u;
                            hb0 = __builtin_amdgcn_exp2f(kb0 * bf_lo(rwc[u])) * hb0 + bf_lo(bwc[u]); hb1 = __builtin_amdgcn_exp2f(kb1 * bf_hi(rwc[u])) * hb1 + bf_hi(bwc[u]);
                            *(unsigned*)(mx + (size_t)k * DM) = cvt_pk_bf16((bf_lo(fwc[u]) + hb0) * bf_lo(gwc[u]), (bf_hi(fwc[u]) + hb1) * bf_hi(gwc[u])); }
#pragma unroll
                        for (int u = 0; u < 8; ++u) { rwc[u] = rwn[u]; bwc[u] = bwn[u]; fwc[u] = fwn[u]; gwc[u] = gwn[u]; }
                    }
                }
            }
        } else if (HAS(14) && ph == 14) {
            THREAD_IDS();
            const float* gf = pp->in[25]; const float* ss4 = SS + 3 * T;
            for (int m = gw; m < T; m += NGW) {
                const float rs = __builtin_amdgcn_rsqf(ss4[m] * (1.0f / DM) + EPS);
                const f32x4* xr = (const f32x4*)(X + (size_t)m * DM) + lane; f32x4* orow = (f32x4*)(pp->out + (size_t)m * DM) + lane;
#pragma unroll
                for (int j = 0; j < 8; ++j) { const f32x4 gg = *((const f32x4*)gf + lane + 64 * j); orow[64 * j] = xr[64 * j] * rs * gg; }
            }
        } else if (MASK & GEMM_MASK) {
            pg8::Gemm g; g.M = T; g.amask = 0; g.astride = 0;
            pg8::StaticOrder S;
#define EPI_INIT(E) do { E.alpha = 1.f; E.base = nullptr; E.Xo = nullptr; E.XBo = nullptr; E.ss_out = nullptr; E.ss_in = nullptr; E.O0 = nullptr; E.O1 = nullptr; E.O2 = nullptr; E.aux = nullptr; E.ba = nullptr; E.bi = nullptr; E.lam = nullptr; } while (0)
            if ((HAS(1) || HAS(11)) && (ph == 1 || ph == 11)) {
                pg8::Epi<pg8::M_SWIGLU> E; EPI_INIT(E);
                g.A = XB; g.Bt = (bf16_t*)(ws + (ph == 1 ? WS_W13_1 : WS_W13_2)); g.N = 2 * DFF; g.K = DM; g.lda = DM; g.ldb = DM; E.O0 = H; E.ss_in = (ph == 1) ? nullptr : SS + T;
                S.init(g.M, g.N, G, bx); pg8::gemm_phase(lds, g, S, E, tid);
            } else if ((HAS(2) || HAS(9) || HAS(12)) && (ph == 2 || ph == 9 || ph == 12)) {
                pg8::Epi<pg8::M_RESID> E; EPI_INIT(E); E.Xo = X; E.XBo = XB;
                if (ph == 2) { g.A = H; g.Bt = (bf16_t*)(ws + WS_W2_1); g.K = DFF; g.lda = DFF; g.ldb = DFF; E.base = pp->in[0]; E.alpha = 0.5f; E.ss_out = SS; }
                else if (ph == 9) { g.A = MIX; g.Bt = (bf16_t*)(ws + WS_WOUT); g.K = DM; g.lda = DM; g.ldb = DM; E.base = X; E.alpha = 1.f; E.ss_out = SS + T; }
                else { g.A = H; g.Bt = (bf16_t*)(ws + WS_W2_2); g.K = DFF; g.lda = DFF; g.ldb = DFF; E.base = X; E.alpha = 0.5f; E.ss_out = SS + 2 * T; }
                g.N = DM;
                S.init(g.M, g.N, G, bx); pg8::gemm_phase(lds, g, S, E, tid);
            } else if (HAS(3) && ph == 3) {
                pg8::Epi<pg8::M_WIN> E; EPI_INIT(E);
                g.A = XB; g.Bt = (bf16_t*)(ws + WS_WIN); g.N = INC; g.K = DM; g.lda = DM; g.ldb = DM; E.ss_in = SS; E.O0 = QKV; E.O1 = U; E.O2 = GY;
                S.init(g.M, g.N, G, bx); pg8::gemm_phase(lds, g, S, E, tid);
            } else if (HAS(5) && ph == 5) {
                pg8::Epi<pg8::M_GATES> E; EPI_INIT(E);
                g.A = UC; g.Bt = (bf16_t*)(ws + WS_WL); g.N = 4096; g.K = 128; g.lda = LRUW; g.ldb = 128; g.amask = 7; g.astride = 256; E.O0 = RA; E.O1 = BXb; E.aux = UC;
                E.ba = pp->in[13]; E.bi = pp->in[15]; E.lam = (const float*)(ws + WS_C8);
                S.init(g.M, g.N, G, bx); pg8::gemm_phase(lds, g, S, E, tid);
            } else if (HAS(10) && ph == 10) {
                pg8::Epi<pg8::M_PLAIN> E; EPI_INIT(E);
                g.A = PB; g.Bt = (bf16_t*)(ws + WS_WP); g.N = DM; g.K = PLED; g.lda = PLED; g.ldb = PLED; E.O0 = PP;
                S.init(g.M, g.N, G, bx); pg8::gemm_phase(lds, g, S, E, tid);
            } else if (HAS(13)) {
                pg8::Epi<pg8::M_PLE> E; EPI_INIT(E);
                g.A = XB; g.Bt = (bf16_t*)(ws + WS_WG); g.N = DM; g.K = DM; g.lda = DM; g.ldb = DM; E.Xo = X; E.base = X; E.ss_in = SS + 2 * T; E.ss_out = SS + 3 * T; E.aux = PP;
                S.init(g.M, g.N, G, bx); pg8::gemm_phase(lds, g, S, E, tid);
            }
#undef EPI_INIT
        }
        if (pi + 1 < nprog && ph != 7 && ph != 9) { if (pi == 0) grid.sync(); else xcd_barrier(xbar); }
    }
}

#if MK_ONE_LAUNCH
#define MEGA_MAIN mega<ALL_MASK>
#else
#define MEGA_MAIN mega<MK_SW>
#endif
extern "C" void kernel_launch(void* const* d_in, const int* in_sizes, int n_in, void* d_out, int out_size, void* d_ws, size_t ws_size, hipStream_t stream) {
    static int grid = 0;
    if (grid == 0) {
        if (n_in != 26 || in_sizes[0] != T * DM || out_size != T * DM || ws_size < WS_END) { fprintf(stderr, "kernel_launch: shape/workspace mismatch (n_in %d, ws %zu)\n", n_in, ws_size); grid = -1; return; }
        int dev = 0, cus = 0, per_cu = 0;
        (void)hipGetDevice(&dev); (void)hipDeviceGetAttribute(&cus, hipDeviceAttributeMultiprocessorCount, dev);
        bool ok = hipFuncSetAttribute((const void*)MEGA_MAIN, hipFuncAttributeMaxDynamicSharedMemorySize, LDS_BYTES) == hipSuccess;
#if !MK_ONE_LAUNCH
        ok = ok && hipFuncSetAttribute((const void*)mega<1u << 0>, hipFuncAttributeMaxDynamicSharedMemorySize, LDS_BYTES) == hipSuccess;
        ok = ok && hipFuncSetAttribute((const void*)mega<1u << 4>, hipFuncAttributeMaxDynamicSharedMemorySize, LDS_BYTES) == hipSuccess;
        ok = ok && hipFuncSetAttribute((const void*)mega<1u << 6>, hipFuncAttributeMaxDynamicSharedMemorySize, LDS_BYTES) == hipSuccess;
        ok = ok && hipFuncSetAttribute((const void*)mega<1u << 7>, hipFuncAttributeMaxDynamicSharedMemorySize, LDS_BYTES) == hipSuccess;
        ok = ok && hipFuncSetAttribute((const void*)mega<1u << 8>, hipFuncAttributeMaxDynamicSharedMemorySize, LDS_BYTES) == hipSuccess;
        ok = ok && hipFuncSetAttribute((const void*)mega<1u << 14>, hipFuncAttributeMaxDynamicSharedMemorySize, LDS_BYTES) == hipSuccess;
        ok = ok && hipFuncSetAttribute((const void*)mega<MK_RES>, hipFuncAttributeMaxDynamicSharedMemorySize, LDS_BYTES) == hipSuccess;
        ok = ok && hipFuncSetAttribute((const void*)mega<1u << 3>, hipFuncAttributeMaxDynamicSharedMemorySize, LDS_BYTES) == hipSuccess;
        ok = ok && hipFuncSetAttribute((const void*)mega<1u << 5>, hipFuncAttributeMaxDynamicSharedMemorySize, LDS_BYTES) == hipSuccess;
        ok = ok && hipFuncSetAttribute((const void*)mega<1u << 10>, hipFuncAttributeMaxDynamicSharedMemorySize, LDS_BYTES) == hipSuccess;
        ok = ok && hipFuncSetAttribute((const void*)mega<1u << 13>, hipFuncAttributeMaxDynamicSharedMemorySize, LDS_BYTES) == hipSuccess;
#endif
        if (!ok) { fprintf(stderr, "kernel_launch: hipFuncSetAttribute failed\n"); grid = -1; return; }
        if (hipOccupancyMaxActiveBlocksPerMultiprocessor(&per_cu, (const void*)MEGA_MAIN, 512, LDS_BYTES) != hipSuccess || per_cu < 1) { fprintf(stderr, "kernel_launch: occupancy query gives %d\n", per_cu); per_cu = 1; }
        (void)hipGetLastError();
        grid = cus * per_cu;
    }
    if (grid < 0) return;
    Params p{};
    for (int i = 0; i < 26; ++i) p.in[i] = (const float*)d_in[i];
    p.out = (float*)d_out; p.ws = (unsigned char*)d_ws;
#if MK_ONE_LAUNCH
#ifdef MK_PROG
    { const unsigned char prog[] = {MK_PROG}; p.nprog = (int)sizeof(prog); for (int i = 0; i < p.nprog; ++i) p.prog[i] = prog[i]; }
#else
    p.nprog = NPH; for (int i = 0; i < NPH; ++i) p.prog[i] = (unsigned char)i;
#endif
    void* args[] = {&p};
    if (hipMemsetAsync((char*)d_ws + WS_BAR, 0, BAR_BYTES, stream) != hipSuccess) { fprintf(stderr, "kernel_launch: memset of barrier words failed\n"); return; }
    hipError_t e = hipLaunchCooperativeKernel((const void*)MEGA_MAIN, dim3(grid), dim3(512), args, LDS_BYTES, stream);
    if (e != hipSuccess) fprintf(stderr, "cooperative launch failed: %s (grid %d)\n", hipGetErrorString(e), grid);
#else
    for (int ph = 0; ph < NPH; ++ph) {
        p.nprog = 1; p.prog[0] = (unsigned char)ph;
        switch (ph) {
        case 0:  hipLaunchKernelGGL(mega<1u << 0>, dim3(grid), dim3(512), LDS_BYTES, stream, p); break;
        case 4:  hipLaunchKernelGGL(mega<1u << 4>, dim3(grid), dim3(512), LDS_BYTES, stream, p); break;
        case 6:  hipLaunchKernelGGL(mega<1u << 6>, dim3(grid), dim3(512), LDS_BYTES, stream, p); break;
        case 7:  hipLaunchKernelGGL(mega<1u << 7>, dim3(grid), dim3(512), LDS_BYTES, stream, p); break;
        case 8:  hipLaunchKernelGGL(mega<1u << 8>, dim3(grid), dim3(512), LDS_BYTES, stream, p); break;
        case 14: hipLaunchKernelGGL(mega<1u << 14>, dim3(grid), dim3(512), LDS_BYTES, stream, p); break;
        case 1: case 11: hipLaunchKernelGGL(mega<MK_SW>, dim3(grid), dim3(512), LDS_BYTES, stream, p); break;
        case 2: case 9: case 12: hipLaunchKernelGGL(mega<MK_RES>, dim3(grid), dim3(512), LDS_BYTES, stream, p); break;
        case 3:  hipLaunchKernelGGL(mega<1u << 3>, dim3(grid), dim3(512), LDS_BYTES, stream, p); break;
        case 5:  hipLaunchKernelGGL(mega<1u << 5>, dim3(grid), dim3(512), LDS_BYTES, stream, p); break;
        case 10: hipLaunchKernelGGL(mega<1u << 10>, dim3(grid), dim3(512), LDS_BYTES, stream, p); break;
        default: hipLaunchKernelGGL(mega<1u << 13>, dim3(grid), dim3(512), LDS_BYTES, stream, p); break;
        }
    }
#endif
}
```

```cpp
#include <hip/hip_runtime.h>
#include <hip/hip_cooperative_groups.h>
#include <cstdio>
#include <cstdint>
namespace cg = cooperative_groups;

#ifndef MK_ONE_LAUNCH
#define MK_ONE_LAUNCH 1
#endif

#define LAS __attribute__((address_space(3)))
typedef unsigned short bf16_t;
typedef short bf16x8 __attribute__((ext_vector_type(8)));
typedef short s16x4 __attribute__((ext_vector_type(4)));
typedef float f32x4 __attribute__((ext_vector_type(4)));
typedef float f32x2 __attribute__((ext_vector_type(2)));
typedef float f32x16 __attribute__((ext_vector_type(16)));
typedef unsigned u32x4 __attribute__((ext_vector_type(4)));
typedef unsigned u32x2 __attribute__((ext_vector_type(2)));

constexpr int BATCH = 2, SEQ = 16384, DM = 2048, T = BATCH * SEQ, DFF = 5632, INC = 3584, PLED = 256;
constexpr int LRUW = 1024, QKVW = 1536, NCH = 128, CL = 128;
constexpr float EPS = 1e-6f;

constexpr size_t MiB = 1u << 20;
constexpr size_t WS_SS = 0;
constexpr size_t WS_ROPE = 1 * MiB, WS_C8 = 1 * MiB + 128 * 1024;
constexpr size_t WS_BAR = 1 * MiB + 512 * 1024, BAR_BYTES = 16384;
constexpr size_t WS_AGGA = 2 * MiB, WS_AGGH = 4 * MiB;
constexpr size_t WS_W13_1 = 8 * MiB, WS_W2_1 = 52 * MiB, WS_W13_2 = 74 * MiB, WS_W2_2 = 118 * MiB;
constexpr size_t WS_WIN = 140 * MiB, WS_WOUT = 154 * MiB, WS_WG = 162 * MiB, WS_WP = 170 * MiB, WS_WL = 171 * MiB;
constexpr size_t WS_PB = 172 * MiB;
constexpr size_t WS_XB = 188 * MiB;
constexpr size_t WS_X = 316 * MiB;
constexpr size_t WS_H = 572 * MiB;
constexpr size_t WS_RA = WS_H, WS_BX = WS_H + 128 * MiB, WS_QKV = WS_H + 256 * MiB;
constexpr size_t WS_END = 924 * MiB;
constexpr size_t DO_U = 0, DO_UC = 64 * MiB, DO_GY = 128 * MiB, DO_MIX = 0, DO_PP = 128 * MiB;
constexpr size_t DO_Q8 = 192 * MiB, DO_K8 = 224 * MiB, DO_V8 = 232 * MiB;

__device__ __forceinline__ unsigned cvt_pk_bf16(float lo, float hi) { unsigned r; asm volatile("v_cvt_pk_bf16_f32 %0, %1, %2" : "=v"(r) : "v"(lo), "v"(hi)); return r; }
__device__ __forceinline__ float bf_lo(unsigned w) { return __uint_as_float(w << 16); }
__device__ __forceinline__ float bf_hi(unsigned w) { return __uint_as_float(w & 0xffff0000u); }
__device__ __forceinline__ float sigmoidf_(float x) { return __builtin_amdgcn_rcpf(1.0f + __expf(-x)); }
__device__ __forceinline__ float wave_sum(float v) {
#pragma unroll
    for (int o = 1; o < 64; o <<= 1) v += __shfl_xor(v, o);
    return v;
}

namespace pg8 {
constexpr int BM = 256, BK = 64, HALF = 128, HTB = HALF * BK * 2, STAGE_BYTES = 8 * HTB, NXCD = 8, WGM = 8;
__host__ __device__ __forceinline__ int lds_byte(int r, int c) { const int st = (r >> 4) * 2 + (c >> 5), rr = r & 15, cc = c & 31, ob = rr * 64 + cc * 2; return st * 1024 + (ob ^ (((ob >> 9) & 1) << 5)); }
__host__ __device__ __forceinline__ void stage_rc(int b, int& R, int& C) { const int st = b / 1024, sb = b % 1024, swz = sb ^ (((sb >> 9) & 1) << 5); R = (st >> 1) * 16 + swz / 64; C = (st & 1) * 32 + (swz % 64) / 2; }
__host__ __device__ __forceinline__ int perm32(int rho) { const int n = rho >> 4, i = rho & 15; return 8 * (i >> 2) + 4 * n + (i & 3); }

struct Unit { int pm, pn; };
struct Gemm { const bf16_t* A; const bf16_t* Bt; int M, N, K, lda, ldb, amask, astride; };

struct StaticOrder {
    int nM, nN, nwg, G, c;
    __device__ void init(int M, int N, int G_, int c_) { nM = M / BM; nN = N / BM; nwg = nM * nN; G = G_; c = c_; }
    __device__ bool next(int i, Unit& u) const {
        const long L = (long)i * G + c; if (L >= nwg) return false;
        int wgid = (int)L; { const int q = nwg / NXCD, r = nwg % NXCD, xcd = wgid % NXCD, off = wgid / NXCD; wgid = (xcd < r ? xcd * (q + 1) : r * (q + 1) + (xcd - r) * q) + off; }
        const int nig = WGM * nN, gid = wgid / nig, fm = gid * WGM, gsz = (nM - fm) < WGM ? (nM - fm) : WGM;
        u.pm = fm + ((wgid % nig) % gsz); u.pn = (wgid % nig) / gsz; return true;
    }
};

enum { M_SWIGLU = 0, M_RESID = 1, M_WIN = 2, M_GATES = 3, M_PLAIN = 4, M_PLE = 5 };
template <int mode> struct Epi {
    float alpha;
    const float* base; float* Xo; bf16_t* XBo; float* ss_out; const float* ss_in;
    bf16_t* O0; bf16_t* O1; bf16_t* O2; const bf16_t* aux;
    const float* ba; const float* bi; const float* lam;
    __device__ __forceinline__ float rs_of(int row) const { return __builtin_amdgcn_rsqf(ss_in[row] * (1.0f / DM) + EPS); }
    __device__ __forceinline__ void operator()(const f32x4 (&acc)[2][2][4][2], const Unit& u, int wr, int wc, int fr, int fq) const {
        const int row0 = u.pm * BM + wr * 64 + fr;
        const int cw = wc * 32 + 8 * fq;
        if constexpr (mode == M_SWIGLU) {
#pragma unroll
            for (int ai = 0; ai < 2; ++ai)
#pragma unroll
                for (int m = 0; m < 4; ++m) {
                    const int row = row0 + ai * HALF + m * 16;
                    const float s = ss_in ? rs_of(row) : 1.0f;
                    u32x4 w; float v[8];
#pragma unroll
                    for (int n = 0; n < 2; ++n)
#pragma unroll
                        for (int e = 0; e < 4; ++e) { const float a = acc[ai][0][m][n][e] * s, b = acc[ai][1][m][n][e] * s; v[4 * n + e] = a * b * sigmoidf_(a); }
                    w.x = cvt_pk_bf16(v[0], v[1]); w.y = cvt_pk_bf16(v[2], v[3]); w.z = cvt_pk_bf16(v[4], v[5]); w.w = cvt_pk_bf16(v[6], v[7]);
                    *(u32x4*)(O0 + (size_t)row * DFF + u.pn * HALF + cw) = w;
                }
        } else if constexpr (mode == M_RESID || mode == M_PLE) {
            f32x4 cx[2][2], nx[2][2]; u32x4 cp_[2], np_[2];
#define RP_LOAD(dx_, dp_, it_) do { const int row_ = row0 + ((it_) >> 2) * HALF + ((it_) & 3) * 16; _Pragma("unroll") for (int bj = 0; bj < 2; ++bj) { const size_t off_ = (size_t)row_ * DM + u.pn * BM + bj * HALF + cw; \
                dx_[bj][0] = *(const f32x4*)(base + off_); dx_[bj][1] = *(const f32x4*)(base + off_ + 4); if (mode == M_PLE) dp_[bj] = *(const u32x4*)(aux + off_); } } while (0)
            RP_LOAD(cx, cp_, 0);
#pragma unroll
            for (int it = 0; it < 8; ++it) {
                const int ai = it >> 2, m = it & 3;
                const int row = row0 + ai * HALF + m * 16;
                if (it + 1 < 8) RP_LOAD(nx, np_, it + 1);
                const float s = (mode == M_PLE) ? rs_of(row) : 1.0f;
                float sq = 0.f;
#pragma unroll
                for (int bj = 0; bj < 2; ++bj) {
                    const size_t off = (size_t)row * DM + u.pn * BM + bj * HALF + cw;
                    f32x4 x0 = cx[bj][0], x1 = cx[bj][1];
                    if (mode == M_PLE) {
                        const u32x4 pw = cp_[bj];
                        const f32x4 a0 = acc[ai][bj][m][0] * s, a1 = acc[ai][bj][m][1] * s;
                        x0[0] += sigmoidf_(a0[0]) * bf_lo(pw.x); x0[1] += sigmoidf_(a0[1]) * bf_hi(pw.x); x0[2] += sigmoidf_(a0[2]) * bf_lo(pw.y); x0[3] += sigmoidf_(a0[3]) * bf_hi(pw.y);
                        x1[0] += sigmoidf_(a1[0]) * bf_lo(pw.z); x1[1] += sigmoidf_(a1[1]) * bf_hi(pw.z); x1[2] += sigmoidf_(a1[2]) * bf_lo(pw.w); x1[3] += sigmoidf_(a1[3]) * bf_hi(pw.w);
                    } else {
                        x0 += acc[ai][bj][m][0] * alpha; x1 += acc[ai][bj][m][1] * alpha;
                    }
                    *(f32x4*)(Xo + off) = x0; *(f32x4*)(Xo + off + 4) = x1;
                    if (mode == M_RESID) { u32x4 w; w.x = cvt_pk_bf16(x0[0], x0[1]); w.y = cvt_pk_bf16(x0[2], x0[3]); w.z = cvt_pk_bf16(x1[0], x1[1]); w.w = cvt_pk_bf16(x1[2], x1[3]); *(u32x4*)(XBo + off) = w; }
                    sq += (x0[0] * x0[0] + x0[1] * x0[1]) + (x0[2] * x0[2] + x0[3] * x0[3]) + (x1[0] * x1[0] + x1[1] * x1[1]) + (x1[2] * x1[2] + x1[3] * x1[3]);
                }
                sq += __shfl_xor(sq, 16); sq += __shfl_xor(sq, 32);
                if (fq == 0) __hip_atomic_fetch_add(ss_out + row, sq, __ATOMIC_RELAXED, __HIP_MEMORY_SCOPE_AGENT);
#pragma unroll
                for (int bj = 0; bj < 2; ++bj) { cx[bj][0] = nx[bj][0]; cx[bj][1] = nx[bj][1]; cp_[bj] = np_[bj]; }
            }
#undef RP_LOAD
        } else if constexpr (mode == M_WIN) {
            const int pn = u.pn;
            bf16_t* dst; int ld, c0;
            if (pn < 6) { dst = O0; ld = QKVW; c0 = pn * BM; } else if (pn < 10) { dst = O1; ld = LRUW; c0 = (pn - 6) * BM; } else { dst = O2; ld = LRUW; c0 = (pn - 10) * BM; }
            const bool act = pn >= 10;
#pragma unroll
            for (int ai = 0; ai < 2; ++ai)
#pragma unroll
                for (int m = 0; m < 4; ++m) {
                    const int row = row0 + ai * HALF + m * 16;
                    const float s = rs_of(row);
#pragma unroll
                    for (int bj = 0; bj < 2; ++bj) {
                        float v[8];
#pragma unroll
                        for (int n = 0; n < 2; ++n)
#pragma unroll
                            for (int e = 0; e < 4; ++e) { float x = acc[ai][bj][m][n][e] * s;
                                if (act) { const float z = 1.5957691216f * (x + 0.044715f * x * x * x); x = x * sigmoidf_(z); }
                                v[4 * n + e] = x; }
                        u32x4 w; w.x = cvt_pk_bf16(v[0], v[1]); w.y = cvt_pk_bf16(v[2], v[3]); w.z = cvt_pk_bf16(v[4], v[5]); w.w = cvt_pk_bf16(v[6], v[7]);
                        *(u32x4*)(dst + (size_t)row * ld + c0 + bj * HALF + cw) = w;
                    }
                }
        } else if constexpr (mode == M_GATES) {
            const int dir = u.pn >> 3, h = u.pn & 7;
            const int chb = h * HALF + cw;
            f32x4 vba[2], vbi[2], c8[2];
#pragma unroll
            for (int n = 0; n < 2; ++n) { vba[n] = *(const f32x4*)(ba + dir * LRUW + chb + 4 * n); vbi[n] = *(const f32x4*)(bi + dir * LRUW + chb + 4 * n); c8[n] = *(const f32x4*)(lam + dir * LRUW + chb + 4 * n); }
            u32x4 uwv[2][4];
#pragma unroll
            for (int ai = 0; ai < 2; ++ai)
#pragma unroll
                for (int m = 0; m < 4; ++m) uwv[ai][m] = *(const u32x4*)(aux + (size_t)(row0 + ai * HALF + m * 16) * LRUW + chb);
#pragma unroll
            for (int ai = 0; ai < 2; ++ai)
#pragma unroll
                for (int m = 0; m < 4; ++m) {
                    const int row = row0 + ai * HALF + m * 16;
                    const u32x4 uw = uwv[ai][m];
                    u32x4 wr_, wb_;
#pragma unroll
                    for (int n = 0; n < 2; ++n) {
                        float rr[4], bx[4];
#pragma unroll
                        for (int e = 0; e < 4; ++e) {
                            const unsigned uword = (n == 0) ? (e < 2 ? uw.x : uw.y) : (e < 2 ? uw.z : uw.w);
                            const float ucv = (e & 1) ? bf_hi(uword) : bf_lo(uword);
                            const float r = sigmoidf_(acc[ai][0][m][n][e] + vba[n][e]), ig = sigmoidf_(acc[ai][1][m][n][e] + vbi[n][e]);
                            const float a2 = __builtin_amdgcn_exp2f(2.0f * c8[n][e] * r);
                            rr[e] = r; bx[e] = __builtin_amdgcn_sqrtf(fmaxf(1.0f - a2, 0.f)) * ig * ucv; }
                        if (n == 0) { wr_.x = cvt_pk_bf16(rr[0], rr[1]); wr_.y = cvt_pk_bf16(rr[2], rr[3]); wb_.x = cvt_pk_bf16(bx[0], bx[1]); wb_.y = cvt_pk_bf16(bx[2], bx[3]); }
                        else { wr_.z = cvt_pk_bf16(rr[0], rr[1]); wr_.w = cvt_pk_bf16(rr[2], rr[3]); wb_.z = cvt_pk_bf16(bx[0], bx[1]); wb_.w = cvt_pk_bf16(bx[2], bx[3]); }
                    }
                    *(u32x4*)(O0 + ((size_t)dir * T + row) * LRUW + chb) = wr_;
                    *(u32x4*)(O1 + ((size_t)dir * T + row) * LRUW + chb) = wb_;
                }
        } else {
#pragma unroll
            for (int ai = 0; ai < 2; ++ai)
#pragma unroll
                for (int m = 0; m < 4; ++m) {
                    const int row = row0 + ai * HALF + m * 16;
#pragma unroll
                    for (int bj = 0; bj < 2; ++bj) {
                        const f32x4 v0 = acc[ai][bj][m][0], v1 = acc[ai][bj][m][1];
                        u32x4 w; w.x = cvt_pk_bf16(v0[0], v0[1]); w.y = cvt_pk_bf16(v0[2], v0[3]); w.z = cvt_pk_bf16(v1[0], v1[1]); w.w = cvt_pk_bf16(v1[2], v1[3]);
                        *(u32x4*)(O0 + (size_t)row * DM + u.pn * BM + bj * HALF + cw) = w;
                    }
                }
        }
    }
};

template <class Epi> __device__ __forceinline__ void gemm_phase(LAS unsigned char* lds, const Gemm g, const StaticOrder& S, const Epi& E, const int tid) {
    const int wid = __builtin_amdgcn_readfirstlane(tid >> 6), lane = tid & 63, wr = wid >> 2, wc = wid & 3, fr = lane & 15, fq = lane >> 4;
    int K = g.K; asm volatile("" : "+s"(K)); const int nt = K / BK;
    unsigned voffA[2], voffB[2];
#pragma unroll
    for (int i = 0; i < 2; ++i) { int R, C; stage_rc(tid * 16 + i * 8192, R, C); const int Rb = (R & ~31) + perm32(R & 31);
        voffA[i] = (unsigned)(R * g.lda + C) * 2u; voffB[i] = (unsigned)(Rb * g.ldb + C) * 2u; }
    const size_t kstep = (size_t)(BK * 2);
    const size_t hstepA = (size_t)HALF * g.lda * 2, hstepB = (size_t)HALF * g.ldb * 2;
    const size_t tstepA = 2 * hstepA, tstepB = 2 * hstepB;
    const unsigned ldsw = (unsigned)wid * 1024u;
    const unsigned ldsbase = (unsigned)(size_t)lds;
    const int aoff = lds_byte(wr * 64 + fr, fq * 8), boff = lds_byte(wc * 32 + fr, fq * 8);
#define PG8_SA(b, h) (((b) * 2 + (h)) * HTB)
#define PG8_SB(b, h) ((4 + (b) * 2 + (h)) * HTB)
#define PG8_STAGE(bufoff, gbase, voff) do { _Pragma("unroll") for (int _i = 0; _i < 2; ++_i) { \
        const unsigned d_ = (unsigned)__builtin_amdgcn_readfirstlane((int)(ldsbase + (unsigned)(bufoff) + ldsw + (unsigned)_i * 8192u)); \
        asm volatile("s_mov_b32 m0, %2\n\ts_nop 0\n\tglobal_load_lds_dwordx4 %0, %1" :: "v"((voff)[_i]), "s"((const char*)(gbase)), "s"(d_) : "memory"); } } while (0)
#define PG8_LDA(dst, b, h) do { _Pragma("unroll") for (int m = 0; m < 4; ++m) _Pragma("unroll") for (int k = 0; k < 2; ++k) dst[m][k] = *(const LAS bf16x8*)(lds + PG8_SA(b, h) + aoff + m * 2048 + k * 1024); } while (0)
#define PG8_LDB(dst, b, h) do { _Pragma("unroll") for (int n = 0; n < 2; ++n) _Pragma("unroll") for (int k = 0; k < 2; ++k) dst[n][k] = *(const LAS bf16x8*)(lds + PG8_SB(b, h) + boff + n * 2048 + k * 1024); } while (0)
#define PG8_MMA(ai, bj, At, Bt) do { __builtin_amdgcn_s_setprio(1); _Pragma("unroll") for (int m = 0; m < 4; ++m) _Pragma("unroll") for (int n = 0; n < 2; ++n) _Pragma("unroll") for (int k = 0; k < 2; ++k) \
        acc[ai][bj][m][n] = __builtin_amdgcn_mfma_f32_16x16x32_bf16(Bt[n][k], At[m][k], acc[ai][bj][m][n], 0, 0, 0); __builtin_amdgcn_s_setprio(0); } while (0)
#define PG8_WAIT_V(n) asm volatile("s_waitcnt vmcnt(" #n ")" ::: "memory")
#define PG8_WAIT_L(n) asm volatile("s_waitcnt lgkmcnt(" #n ")" ::: "memory")
#define PG8_BAR __builtin_amdgcn_s_barrier()
#define PG8_SCHED __builtin_amdgcn_sched_barrier(0)
    Unit cur, nxt; int ui = 0;
    if (!S.next(0, cur)) return;
    f32x4 acc[2][2][4][2];
#pragma unroll
    for (int a = 0; a < 2; ++a)
#pragma unroll
        for (int b = 0; b < 2; ++b)
#pragma unroll
            for (int m = 0; m < 4; ++m)
#pragma unroll
                for (int n = 0; n < 2; ++n) acc[a][b][m][n] = (f32x4){0.f, 0.f, 0.f, 0.f};
    bf16x8 At[4][2], B0[2][2], B1[2][2];
    const char* cA = (const char*)g.A + (size_t)cur.pm * tstepA + (size_t)(cur.pn & g.amask) * g.astride; const char* cB = (const char*)g.Bt + (size_t)cur.pn * tstepB;
    PG8_STAGE(PG8_SB(0, 0), cB, voffB); PG8_STAGE(PG8_SB(0, 1), cB + hstepB, voffB); PG8_STAGE(PG8_SA(0, 0), cA, voffA); PG8_STAGE(PG8_SA(0, 1), cA + hstepA, voffA);
    if (wr == 1) PG8_BAR;
    PG8_WAIT_V(2); PG8_BAR;
    PG8_STAGE(PG8_SB(1, 0), cB + kstep, voffB); PG8_STAGE(PG8_SA(1, 0), cA + kstep, voffA); PG8_STAGE(PG8_SB(1, 1), cB + hstepB + kstep, voffB);
    PG8_WAIT_V(6); PG8_BAR;
    for (;;) {
        const bool has_next = S.next(ui + 1, nxt);
        const char* nA = has_next ? (const char*)g.A + (size_t)nxt.pm * tstepA + (size_t)(nxt.pn & g.amask) * g.astride : cA; const char* nB = has_next ? (const char*)g.Bt + (size_t)nxt.pn * tstepB : cB;
        for (int t = 0; t < nt; t += 2) {
            const bool last = (t == nt - 2);
            const char* a1 = cA + (size_t)(t + 1) * kstep;
            const char* a2 = last ? nA : cA + (size_t)(t + 2) * kstep; const char* b2 = last ? nB : cB + (size_t)(t + 2) * kstep;
            const char* a3 = a2 + kstep; const char* b3 = b2 + kstep;
            PG8_LDB(B0, 0, 0); PG8_LDB(B1, 0, 1); PG8_SCHED; PG8_LDA(At, 0, 0); PG8_STAGE(PG8_SA(1, 1), a1 + hstepA, voffA);
            PG8_WAIT_V(8); PG8_WAIT_L(0); PG8_BAR; PG8_MMA(0, 0, At, B0); PG8_MMA(0, 1, At, B1); PG8_BAR; PG8_SCHED;
            PG8_LDA(At, 0, 1); PG8_STAGE(PG8_SB(0, 0), b2, voffB); PG8_STAGE(PG8_SB(0, 1), b2 + hstepB, voffB); PG8_STAGE(PG8_SA(0, 0), a2, voffA);
            PG8_WAIT_V(8); PG8_WAIT_L(0); PG8_BAR; PG8_MMA(1, 0, At, B0); PG8_MMA(1, 1, At, B1); PG8_BAR; PG8_SCHED;
            PG8_LDB(B0, 1, 0); PG8_LDB(B1, 1, 1); PG8_SCHED; PG8_LDA(At, 1, 0); PG8_STAGE(PG8_SA(0, 1), a2 + hstepA, voffA);
            PG8_WAIT_V(8); PG8_WAIT_L(0); PG8_BAR; PG8_MMA(0, 0, At, B0); PG8_MMA(0, 1, At, B1); PG8_BAR; PG8_SCHED;
            PG8_LDA(At, 1, 1); PG8_STAGE(PG8_SB(1, 0), b3, voffB); PG8_STAGE(PG8_SB(1, 1), b3 + hstepB, voffB); PG8_STAGE(PG8_SA(1, 0), a3, voffA);
            PG8_WAIT_V(8); PG8_WAIT_L(0); PG8_BAR; PG8_MMA(1, 0, At, B0); PG8_MMA(1, 1, At, B1); PG8_BAR; PG8_SCHED;
        }
        if (wr == 0) PG8_BAR;
        E(acc, cur, wr, wc, fr, fq);
        if (!has_next) break;
#pragma unroll
        for (int a = 0; a < 2; ++a)
#pragma unroll
            for (int b = 0; b < 2; ++b)
#pragma unroll
                for (int m = 0; m < 4; ++m)
#pragma unroll
                    for (int n = 0; n < 2; ++n) acc[a][b][m][n] = (f32x4){0.f, 0.f, 0.f, 0.f};
        cur = nxt; cA = nA; cB = nB; ++ui;
        if (wr == 1) PG8_BAR;
    }
    PG8_WAIT_V(0);
    PG8_BAR;
#undef PG8_SA
#undef PG8_SB
#undef PG8_STAGE
#undef PG8_LDA
#undef PG8_LDB
#undef PG8_MMA
#undef PG8_WAIT_V
#undef PG8_WAIT_L
#undef PG8_BAR
#undef PG8_SCHED
}
}

namespace att {
constexpr int D = 128, NW = 8, QBLK = 32, KVBLK = 64;
constexpr float SCALE = 0.088388347648318440f;
constexpr float THR = 8.f;
constexpr int LDQ = QKVW, LDK = QKVW, LDO = DM;
constexpr size_t SHM_V = KVBLK * D * 2, SHM_K = KVBLK * D * 2, SHM_ATTN = 2 * SHM_V + 2 * SHM_K + NW * 64 * 4;
#define KSWZ(row, colB) ((row) * 256 + ((colB) ^ (((row) & 7) << 4)))
#define SBAR() __builtin_amdgcn_sched_barrier(0)
__device__ __forceinline__ int crow(int r, int hi) { return (r & 3) + 8 * (r >> 2) + 4 * hi; }
__device__ __forceinline__ void partialSM(f32x16& p0, f32x16& p1, float& m_reg, float& mn, float& alpha) {
  constexpr float C = SCALE * 1.4426950408889634f;
  float pmax = p0[0]; for (int r = 1; r < 16; ++r) pmax = fmaxf(pmax, p0[r]); for (int r = 0; r < 16; ++r) pmax = fmaxf(pmax, p1[r]);
  { auto rr = __builtin_amdgcn_permlane32_swap(__float_as_uint(pmax), __float_as_uint(pmax), false, false);
    pmax = fmaxf(__uint_as_float(rr[0]), __uint_as_float(rr[1])); }
  if (__builtin_expect(__all(pmax - m_reg <= THR / SCALE), 1)) { mn = m_reg; alpha = 1.f; }
  else { mn = fmaxf(m_reg, pmax); alpha = __builtin_amdgcn_exp2f((m_reg - mn) * C); m_reg = mn; }
  float mnC = -mn * C;
  for (int r = 0; r < 16; ++r) p0[r] = fmaf(p0[r], C, mnC); for (int r = 0; r < 16; ++r) p1[r] = fmaf(p1[r], C, mnC);
  for (int r = 0; r < 16; ++r) p0[r] = __builtin_amdgcn_exp2f(p0[r]);
}
__device__ __forceinline__ void finishSM(f32x16& p0, f32x16& p1, float alpha, float& l_reg, bf16x8& pa0, bf16x8& pa1, bf16x8& pa2, bf16x8& pa3) {
  for (int r = 0; r < 16; ++r) p1[r] = __builtin_amdgcn_exp2f(p1[r]);
  float ps = 0; for (int r = 0; r < 16; ++r) ps += p0[r]; for (int r = 0; r < 16; ++r) ps += p1[r];
  { auto rr = __builtin_amdgcn_permlane32_swap(__float_as_uint(ps), __float_as_uint(ps), false, false);
    ps = __uint_as_float(rr[0]) + __uint_as_float(rr[1]); }
  l_reg = l_reg * alpha + ps;
#define PK4(P, BASE, OUT) do { unsigned a0 = cvt_pk_bf16(P[BASE + 0], P[BASE + 1]), a1 = cvt_pk_bf16(P[BASE + 2], P[BASE + 3]);   \
    unsigned b0 = cvt_pk_bf16(P[BASE + 4], P[BASE + 5]), b1 = cvt_pk_bf16(P[BASE + 6], P[BASE + 7]);                              \
    auto r0 = __builtin_amdgcn_permlane32_swap(a0, b0, false, false); auto r1 = __builtin_amdgcn_permlane32_swap(a1, b1, false, false); \
    u32x4 w = {r0[0], r1[0], r0[1], r1[1]}; OUT = *reinterpret_cast<bf16x8*>(&w); } while (0)
  PK4(p0, 0, pa0); PK4(p0, 8, pa1); PK4(p1, 0, pa2); PK4(p1, 8, pa3);
#undef PK4
}
__device__ __forceinline__ void qkt(f32x16& p0, f32x16& p1, const bf16_t* Ks, const bf16x8* qr, int r32, int hi) {
  p0 = f32x16{}; p1 = f32x16{};
  for (int d0 = 0; d0 < 8; ++d0) { int cb = (d0 * 16 + hi * 8) * 2;
    bf16x8 b0 = *reinterpret_cast<const bf16x8*>((const char*)Ks + KSWZ(r32, cb));
    bf16x8 b1 = *reinterpret_cast<const bf16x8*>((const char*)Ks + KSWZ(32 + r32, cb));
    p0 = __builtin_amdgcn_mfma_f32_32x32x16_bf16(b0, qr[d0], p0, 0, 0, 0);
    p1 = __builtin_amdgcn_mfma_f32_32x32x16_bf16(b1, qr[d0], p1, 0, 0, 0); }
}
__device__ __forceinline__ int v_st(int k, int c) { const int kk = (k & ~0xC) | ((k & 4) << 1) | ((k & 8) >> 1); return ((kk >> 3) * 4 + (c >> 5)) * 512 + ((kk & 7) * 32 + (c & 31)) * 2; }
__device__ __forceinline__ int v_rd_base(int lane) { return ((lane & 3) << 3) | (((lane >> 2) & 3) << 6) | (((lane >> 4) & 1) << 5) | (((lane >> 5) & 1) << 8); }
constexpr int v_rd_off(int d0, int ks, int half) { return d0 * 512 + ks * 4096 + half * 2048; }
template <int OFF> __device__ __forceinline__ s16x4 tr_read(int vb) {
  s16x4 r; asm volatile("ds_read_b64_tr_b16 %0, %1 offset:%2" : "=&v"(r) : "v"(vb), "i"(OFF) : "memory"); return r;
}
template <int D0> __device__ __forceinline__ void pv_one(f32x16& od, int vb, bf16x8 pa0, bf16x8 pa1, bf16x8 pa2, bf16x8 pa3) {
  const s16x4 l0 = tr_read<v_rd_off(D0, 0, 0)>(vb), h0 = tr_read<v_rd_off(D0, 0, 1)>(vb), l1 = tr_read<v_rd_off(D0, 1, 0)>(vb), h1 = tr_read<v_rd_off(D0, 1, 1)>(vb);
  const s16x4 l2 = tr_read<v_rd_off(D0, 2, 0)>(vb), h2 = tr_read<v_rd_off(D0, 2, 1)>(vb), l3 = tr_read<v_rd_off(D0, 3, 0)>(vb), h3 = tr_read<v_rd_off(D0, 3, 1)>(vb);
  asm volatile("s_waitcnt lgkmcnt(0)" ::: "memory"); SBAR();
#define PK(L, H) (bf16x8){L[0], L[1], L[2], L[3], H[0], H[1], H[2], H[3]}
  od = __builtin_amdgcn_mfma_f32_32x32x16_bf16(pa0, PK(l0, h0), od, 0, 0, 0);
  od = __builtin_amdgcn_mfma_f32_32x32x16_bf16(pa1, PK(l1, h1), od, 0, 0, 0);
  od = __builtin_amdgcn_mfma_f32_32x32x16_bf16(pa2, PK(l2, h2), od, 0, 0, 0);
  od = __builtin_amdgcn_mfma_f32_32x32x16_bf16(pa3, PK(l3, h3), od, 0, 0, 0);
#undef PK
}
__device__ __forceinline__ void pv_d0(f32x16* o, int vb, bf16x8 pa0, bf16x8 pa1, bf16x8 pa2, bf16x8 pa3) {
  pv_one<0>(o[0], vb, pa0, pa1, pa2, pa3); pv_one<1>(o[1], vb, pa0, pa1, pa2, pa3); pv_one<2>(o[2], vb, pa0, pa1, pa2, pa3); pv_one<3>(o[3], vb, pa0, pa1, pa2, pa3);
}
__device__ __forceinline__ void glds16(unsigned voff, const void* sbase, unsigned lds_dst) {
  unsigned keep;
  asm volatile("s_mov_b32 %0, m0\n\ts_mov_b32 m0, %3\n\ts_nop 0\n\tglobal_load_lds_dwordx4 %1, %2\n\ts_mov_b32 m0, %0" : "=&s"(keep) : "v"(voff), "s"(sbase), "s"(lds_dst) : "memory");
}
#define WAIT_BAR(N) asm volatile("s_waitcnt vmcnt(" #N ") lgkmcnt(0)\n\ts_barrier" ::: "memory")
constexpr int SLOT = 16384, LK = 0, LV = 3 * SLOT, LWS = 6 * SLOT;
__device__ __forceinline__ void attn_dense_body(const bf16_t* __restrict__ Qb, const bf16_t* __restrict__ Kh, const bf16_t* __restrict__ Vh,
                                                bf16_t* __restrict__ Ob, int seq, char* lds, const int tid) {
  const int wid = __builtin_amdgcn_readfirstlane(tid >> 6), lane = tid & 63, r32 = lane & 31, hi = lane >> 5;
  const unsigned lds0 = (unsigned)(uintptr_t)lds;
  float* ws = (float*)(lds + LWS) + wid * 64; float* li_l = ws; float* al_l = ws + 32;
  float m_reg = -1e30f, l_reg = 0; f32x16 o[4] = {}; bf16x8 qr[8];
  const bf16_t* Qw = Qb + (long)(wid * QBLK + r32) * LDQ + hi * 8;
#pragma unroll
  for (int d0 = 0; d0 < 8; ++d0) qr[d0] = *reinterpret_cast<const bf16x8*>(Qw + d0 * 16);
  unsigned kof[2], vof[2];
#pragma unroll
  for (int i = 0; i < 2; ++i) { const int S = (i * 8 + wid) * 1024 + lane * 16;
    const int krow = S >> 8, kcolB = (S & 255) ^ ((krow & 7) << 4); kof[i] = (unsigned)(krow * (LDK * 2) + kcolB);
    const int sub = S >> 9, kk = (sub >> 2) * 8 + ((S & 511) >> 6), k = (kk & ~0xC) | ((kk & 4) << 1) | ((kk & 8) >> 1), c = (sub & 3) * 32 + ((S & 63) >> 1);
    vof[i] = (unsigned)(k * (LDK * 2) + c * 2); }
  const unsigned kdst = lds0 + LK + wid * 1024, vdst = lds0 + LV + wid * 1024;
  const int vb0 = (int)lds0 + LV + v_rd_base(lane);
#define DMA_K(t, so) do { const char* b_ = (const char*)Kh + (size_t)(t) * (KVBLK * LDK * 2); const unsigned d_ = (unsigned)__builtin_amdgcn_readfirstlane(kdst + (so)); glds16(kof[0], b_, d_); glds16(kof[1], b_, d_ + 8192u); } while (0)
#define DMA_V(t, so) do { const char* b_ = (const char*)Vh + (size_t)(t) * (KVBLK * LDK * 2); const unsigned d_ = (unsigned)__builtin_amdgcn_readfirstlane(vdst + (so)); glds16(vof[0], b_, d_); glds16(vof[1], b_, d_ + 8192u); } while (0)
#define RESC(a) do { if (__any((a) < 1.f)) { if (hi == 0) al_l[r32] = (a); asm volatile("s_waitcnt lgkmcnt(0)" ::: "memory"); \
    for (int d = 0; d < 4; ++d) for (int r = 0; r < 16; ++r) o[d][r] *= al_l[crow(r, hi)]; } } while (0)
#define KPTR(so) ((const bf16_t*)(lds + LK + (so)))
  f32x16 pA0, pA1, pB0, pB1; float mnA, mnB, alA, alB; bf16x8 pa0, pa1, pa2, pa3; const int NT = seq / KVBLK;
  DMA_K(0, 0); DMA_V(0, 0); DMA_K(1, SLOT);
  WAIT_BAR(0);
  DMA_K(2, 2 * SLOT); DMA_V(1, SLOT);
  qkt(pA0, pA1, KPTR(0), qr, r32, hi); partialSM(pA0, pA1, m_reg, mnA, alA);
  WAIT_BAR(4);
  int s0 = 0, s1 = SLOT, s2 = 2 * SLOT;
#define ROT() do { const int t_ = s0; s0 = s1; s1 = s2; s2 = t_; } while (0)
  for (int j = 1; j + 1 < NT; j += 2) {
    DMA_K(j + 2, s0); DMA_V(j + 1, s2);
    SBAR(); qkt(pB0, pB1, KPTR(s1), qr, r32, hi);
    finishSM(pA0, pA1, alA, l_reg, pa0, pa1, pa2, pa3); SBAR();
    pv_d0(o, vb0 + s0, pa0, pa1, pa2, pa3); partialSM(pB0, pB1, m_reg, mnB, alB);
    RESC(alB);
    WAIT_BAR(4); ROT();
    { const int tk = (j + 3 < NT) ? j + 3 : NT - 1; DMA_K(tk, s0); } DMA_V(j + 2, s2);
    SBAR(); qkt(pA0, pA1, KPTR(s1), qr, r32, hi);
    finishSM(pB0, pB1, alB, l_reg, pa0, pa1, pa2, pa3); SBAR();
    pv_d0(o, vb0 + s0, pa0, pa1, pa2, pa3); partialSM(pA0, pA1, m_reg, mnA, alA);
    RESC(alA);
    WAIT_BAR(4); ROT();
  }
  SBAR(); qkt(pB0, pB1, KPTR(s1), qr, r32, hi);
  finishSM(pA0, pA1, alA, l_reg, pa0, pa1, pa2, pa3); SBAR();
  pv_d0(o, vb0 + s0, pa0, pa1, pa2, pa3); partialSM(pB0, pB1, m_reg, mnB, alB);
  RESC(alB);
  WAIT_BAR(0);
  finishSM(pB0, pB1, alB, l_reg, pa0, pa1, pa2, pa3); SBAR();
  pv_d0(o, vb0 + s1, pa0, pa1, pa2, pa3);
  if (hi == 0) li_l[r32] = l_reg; asm volatile("s_waitcnt lgkmcnt(0)" ::: "memory");
  float rli[16];
#pragma unroll
  for (int r = 0; r < 16; ++r) rli[r] = __builtin_amdgcn_rcpf(li_l[crow(r, hi)]);
  WAIT_BAR(0);
  bf16_t* stg = (bf16_t*)lds + wid * 4096;
#pragma unroll
  for (int r = 0; r < 16; ++r) { const int orow = crow(r, hi);
#pragma unroll
    for (int d0 = 0; d0 < 4; ++d0) { const unsigned w = cvt_pk_bf16(o[d0][r] * rli[r], 0.f); stg[orow * 128 + d0 * 32 + r32] = (bf16_t)(w & 0xffffu); } }
  asm volatile("s_waitcnt lgkmcnt(0)" ::: "memory");
  bf16_t* Ow = Ob + (long)(wid * QBLK) * LDO;
#pragma unroll
  for (int i = 0; i < 8; ++i) { const int row = i * 4 + (lane >> 4), ch = lane & 15; const u32x4 v = *(const u32x4*)(stg + row * 128 + ch * 8); *(u32x4*)(Ow + (long)row * LDO + ch * 8) = v; }
  WAIT_BAR(0);
#undef DMA_K
#undef DMA_V
#undef RESC
#undef KPTR
#undef ROT
}
#undef WAIT_BAR

typedef int v8i __attribute__((ext_vector_type(8)));
typedef int v4i __attribute__((ext_vector_type(4)));
constexpr int SLOT8 = 8192, LK8 = 0, LV8 = 3 * SLOT8, LWS8 = 65536;
constexpr float THR8 = 3.f, POFF8 = 4.f;
#define KSW8(row, byte) ((row) * 128 + (((((byte) >> 4) ^ (((row) >> 1) & 7))) << 4) + ((byte) & 15))
#define VSW8(col, byte) ((col) * 64 + (((((byte) >> 4) ^ (((col) >> 2) & 3))) << 4) + ((byte) & 15))
__device__ __forceinline__ v8i cat8(v4i a, v4i b) { return (v8i){a[0], a[1], a[2], a[3], b[0], b[1], b[2], b[3]}; }
constexpr float THRL8 = THR8 * 1.4426950408889634f;
template <bool FIRST> __device__ __forceinline__ void partialSM8(f32x16& p0, f32x16& p1, float& m_ref, f32x16& negm, float& alpha) {
  float pmax = p0[0]; for (int r = 1; r < 16; ++r) pmax = fmaxf(pmax, p0[r]); for (int r = 0; r < 16; ++r) pmax = fmaxf(pmax, p1[r]);
  { auto rr = __builtin_amdgcn_permlane32_swap(__float_as_uint(pmax), __float_as_uint(pmax), false, false);
    pmax = fmaxf(__uint_as_float(rr[0]), __uint_as_float(rr[1])); }
  const float delta = pmax - POFF8;
  alpha = 1.f;
  if (FIRST || !__builtin_expect(__all(delta <= THRL8), 1)) {
    const float dl = FIRST ? delta : fmaxf(delta, 0.f);
    m_ref += dl;
    for (int r = 0; r < 16; ++r) { p0[r] -= dl; p1[r] -= dl; }
    const float nm = POFF8 - m_ref;
    for (int r = 0; r < 16; ++r) negm[r] = nm;
    if (!FIRST) alpha = __builtin_amdgcn_exp2f(-dl);
  }
  for (int r = 0; r < 16; ++r) p0[r] = __builtin_amdgcn_exp2f(p0[r]);
}
__device__ __forceinline__ void finishSM8(f32x16& p0, f32x16& p1, v8i& pa) {
  for (int r = 0; r < 16; ++r) p1[r] = __builtin_amdgcn_exp2f(p1[r]);
#pragma unroll
  for (int w = 0; w < 4; ++w) { int x = 0; x = __builtin_amdgcn_cvt_pk_fp8_f32(p0[4 * w], p0[4 * w + 1], x, false); x = __builtin_amdgcn_cvt_pk_fp8_f32(p0[4 * w + 2], p0[4 * w + 3], x, true); pa[w] = x; }
#pragma unroll
  for (int w = 0; w < 4; ++w) { int x = 0; x = __builtin_amdgcn_cvt_pk_fp8_f32(p1[4 * w], p1[4 * w + 1], x, false); x = __builtin_amdgcn_cvt_pk_fp8_f32(p1[4 * w + 2], p1[4 * w + 3], x, true); pa[4 + w] = x; }
}
__device__ __forceinline__ void qkt8(f32x16& p0, f32x16& p1, const char* Ks, const v8i* qr, const f32x16& negm, int r32, int hi) {
#pragma unroll
  for (int c = 0; c < 2; ++c) { const int b0 = 64 * c + 32 * hi;
    const v8i a0 = cat8(*reinterpret_cast<const v4i*>(Ks + KSW8(r32, b0)), *reinterpret_cast<const v4i*>(Ks + KSW8(r32, b0 + 16)));
    const v8i a1 = cat8(*reinterpret_cast<const v4i*>(Ks + KSW8(32 + r32, b0)), *reinterpret_cast<const v4i*>(Ks + KSW8(32 + r32, b0 + 16)));
    if (c == 0) { p0 = __builtin_amdgcn_mfma_scale_f32_32x32x64_f8f6f4(a0, qr[c], negm, 0, 0, 0, 0, 0, 0); p1 = __builtin_amdgcn_mfma_scale_f32_32x32x64_f8f6f4(a1, qr[c], negm, 0, 0, 0, 0, 0, 0); }
    else { p0 = __builtin_amdgcn_mfma_scale_f32_32x32x64_f8f6f4(a0, qr[c], p0, 0, 0, 0, 0, 0, 0); p1 = __builtin_amdgcn_mfma_scale_f32_32x32x64_f8f6f4(a1, qr[c], p1, 0, 0, 0, 0, 0, 0); } }
}
__device__ __forceinline__ void pv8(f32x16* o, const char* Vs, v8i pa, int r32, int hi) {
#pragma unroll
  for (int d0 = 0; d0 < 4; ++d0) { const int col = 32 * d0 + r32;
    const v8i b = cat8(*reinterpret_cast<const v4i*>(Vs + VSW8(col, 32 * hi)), *reinterpret_cast<const v4i*>(Vs + VSW8(col, 32 * hi + 16)));
    o[d0] = __builtin_amdgcn_mfma_scale_f32_32x32x64_f8f6f4(pa, b, o[d0], 0, 0, 0, 0, 0, 0); }
  const int one4 = 0x38383838;
  const v8i ones = (v8i){one4, one4, one4, one4, one4, one4, one4, one4};
  o[4] = __builtin_amdgcn_mfma_scale_f32_32x32x64_f8f6f4(pa, ones, o[4], 0, 0, 0, 0, 0, 0);
}
__device__ __forceinline__ void attn_fp8_body(const unsigned char* __restrict__ Q8w, const unsigned char* __restrict__ K8t, const unsigned char* __restrict__ V8t,
                                              bf16_t* __restrict__ Ob, int seq, char* lds, const int tid) {
  const int wid = __builtin_amdgcn_readfirstlane(tid >> 6), lane = tid & 63, r32 = lane & 31, hi = lane >> 5;
  const unsigned lds0 = (unsigned)(uintptr_t)lds;
  float* al_l = (float*)(lds + LWS8) + wid * 64;
  float m_ref = 0.f; f32x16 o[5] = {}; v8i qr[2]; f32x16 negm; for (int r = 0; r < 16; ++r) negm[r] = POFF8; asm volatile("" : "+v"(negm));
  { const unsigned char* qp = Q8w + (size_t)(wid * QBLK + r32) * 1024 + 32 * hi;
#pragma unroll
    for (int c = 0; c < 2; ++c) qr[c] = cat8(*reinterpret_cast<const v4i*>(qp + 64 * c), *reinterpret_cast<const v4i*>(qp + 64 * c + 16)); }
  unsigned kof, vof;
  { const int S = wid * 1024 + lane * 16;
    const int krow = S >> 7, kch = ((S >> 4) & 7) ^ ((krow >> 1) & 7); kof = (unsigned)(krow * 256 + kch * 16);
    const int vcol = S >> 6, vch = ((S >> 4) & 3) ^ ((vcol >> 2) & 3); vof = (unsigned)(vcol * 64 + vch * 16); }
  const unsigned kdst = lds0 + LK8 + wid * 1024, vdst = lds0 + LV8 + wid * 1024;
#define WAIT_BAR(N) asm volatile("s_waitcnt vmcnt(" #N ") lgkmcnt(0)\n\ts_barrier" ::: "memory")
#define DMA_K(t, so) do { const char* b_ = (const char*)K8t + (size_t)(t) * (KVBLK * 256); glds16(kof, b_, (unsigned)__builtin_amdgcn_readfirstlane(kdst + (so))); } while (0)
#define DMA_V(t, so) do { const char* b_ = (const char*)V8t + (size_t)(t) * 8192; glds16(vof, b_, (unsigned)__builtin_amdgcn_readfirstlane(vdst + (so))); } while (0)
#define RESC(a) do { if (__any((a) < 1.f)) { if (hi == 0) al_l[r32] = (a); asm volatile("s_waitcnt lgkmcnt(0)" ::: "memory"); \
    for (int d = 0; d < 5; ++d) for (int r = 0; r < 16; ++r) o[d][r] *= al_l[crow(r, hi)]; } } while (0)
#define KP8(so) ((const char*)(lds + LK8 + (so)))
#define VP8(so) ((const char*)(lds + LV8 + (so)))
  f32x16 pA0, pA1, pB0, pB1; float alA, alB; v8i pa; const int NT = seq / KVBLK;
  DMA_K(0, 0); DMA_V(0, 0); DMA_K(1, SLOT8);
  WAIT_BAR(0);
  DMA_K(2, 2 * SLOT8); DMA_V(1, SLOT8);
  qkt8(pA0, pA1, KP8(0), qr, negm, r32, hi); partialSM8<true>(pA0, pA1, m_ref, negm, alA);
  WAIT_BAR(2);
  int s0 = 0, s1 = SLOT8, s2 = 2 * SLOT8;
#define ROT() do { const int t_ = s0; s0 = s1; s1 = s2; s2 = t_; } while (0)
  for (int j = 1; j + 1 < NT; j += 2) {
    DMA_K(j + 2, s0); DMA_V(j + 1, s2);
    SBAR(); qkt8(pB0, pB1, KP8(s1), qr, negm, r32, hi);
    finishSM8(pA0, pA1, pa); SBAR();
    pv8(o, VP8(s0), pa, r32, hi); partialSM8<false>(pB0, pB1, m_ref, negm, alB);
    RESC(alB);
    WAIT_BAR(2); ROT();
    { const int tk = (j + 3 < NT) ? j + 3 : NT - 1; DMA_K(tk, s0); } DMA_V(j + 2, s2);
    SBAR(); qkt8(pA0, pA1, KP8(s1), qr, negm, r32, hi);
    finishSM8(pB0, pB1, pa); SBAR();
    pv8(o, VP8(s0), pa, r32, hi); partialSM8<false>(pA0, pA1, m_ref, negm, alA);
    RESC(alA);
    WAIT_BAR(2); ROT();
  }
  SBAR(); qkt8(pB0, pB1, KP8(s1), qr, negm, r32, hi);
  finishSM8(pA0, pA1, pa); SBAR();
  pv8(o, VP8(s0), pa, r32, hi); partialSM8<false>(pB0, pB1, m_ref, negm, alB);
  RESC(alB);
  WAIT_BAR(0);
  finishSM8(pB0, pB1, pa); SBAR();
  pv8(o, VP8(s1), pa, r32, hi);
  float rli[16];
#pragma unroll
  for (int r = 0; r < 16; ++r) rli[r] = __builtin_amdgcn_rcpf(o[4][r]);
  WAIT_BAR(0);
  bf16_t* stg = (bf16_t*)lds + wid * 4096;
#pragma unroll
  for (int r = 0; r < 16; ++r) { const int orow = crow(r, hi);
#pragma unroll
    for (int d0 = 0; d0 < 4; ++d0) { const unsigned w = cvt_pk_bf16(o[d0][r] * rli[r], 0.f); stg[orow * 128 + d0 * 32 + r32] = (bf16_t)(w & 0xffffu); } }
  asm volatile("s_waitcnt lgkmcnt(0)" ::: "memory");
  bf16_t* Ow = Ob + (long)(wid * QBLK) * LDO;
#pragma unroll
  for (int i = 0; i < 8; ++i) { const int row = i * 4 + (lane >> 4), ch = lane & 15; const u32x4 v = *(const u32x4*)(stg + row * 128 + ch * 8); *(u32x4*)(Ow + (long)row * LDO + ch * 8) = v; }
  WAIT_BAR(0);
#undef WAIT_BAR
#undef DMA_K
#undef DMA_V
#undef RESC
#undef KP8
#undef VP8
#undef ROT
}
#undef KSWZ
#undef SBAR
}

#define XB_TMO      128
#define XB_XCNT(j)  (256  + 64 * (j))
#define XB_XSUB(j)  (1280 + 64 * (j))
#define XB_XGEN(j)  (2304 + 64 * (j))
#define XB_TOP      3328
#define XB_TOPGEN   3392
#define XCD_BAR_WORDS 3456
#define XB_SPIN_CAP (1u << 18)

__device__ __forceinline__ unsigned xb_ld(unsigned* p)              { return __hip_atomic_load(p, __ATOMIC_RELAXED, __HIP_MEMORY_SCOPE_AGENT); }
__device__ __forceinline__ unsigned xb_add(unsigned* p, unsigned v) { return __hip_atomic_fetch_add(p, v, __ATOMIC_RELAXED, __HIP_MEMORY_SCOPE_AGENT); }
__device__ __forceinline__ unsigned xb_xcc_id() { return (unsigned)__builtin_amdgcn_s_getreg((3 << 11) | 20) & 0xFu; }
#define XB_SPIN(cond, bar) do { unsigned _sp = 0; while (cond) { __builtin_amdgcn_s_sleep(1); \
    if ((++_sp & 255u) == 0u) { if (xb_ld(&(bar)[XB_TMO])) break; if (_sp > XB_SPIN_CAP) { atomicAdd(&(bar)[XB_TMO], 1u); break; } } } } while (0)

struct XcdBarrier {
    unsigned* bar; unsigned x;
    volatile LAS unsigned* st;
};

__device__ __forceinline__ XcdBarrier xcd_barrier_post(unsigned* bar, volatile LAS unsigned* st) {
    XcdBarrier b; b.bar = bar; b.x = xb_xcc_id(); b.st = st;
    if (threadIdx.x == 0) (void)xb_add(&bar[XB_XCNT(b.x)], 1u);
    return b;
}
__device__ __forceinline__ void xcd_barrier_complete(unsigned* bar, unsigned x, unsigned& nloc, unsigned& nx) {
    const unsigned G = gridDim.x * gridDim.y * gridDim.z;
    unsigned sum, cnt, mine, sp = 0u;
    for (;;) {
        sum = 0u; cnt = 0u; mine = 0u;
#pragma unroll
        for (unsigned j = 0; j < 16; ++j) { const unsigned c = xb_ld(&bar[XB_XCNT(j)]); sum += c; cnt += (c > 0u) ? 1u : 0u; mine = (j == x) ? c : mine; }
        if (sum == G) break;
        __builtin_amdgcn_s_sleep(1);
        if ((++sp & 255u) == 0u) { if (xb_ld(&bar[XB_TMO])) break; if (sp > XB_SPIN_CAP) { atomicAdd(&bar[XB_TMO], 1u); break; } }
    }
    nloc = mine > 0u ? mine : 1u; nx = cnt > 0u ? cnt : 1u;
}

__device__ __forceinline__ void xcd_barrier(const XcdBarrier& b) {
    asm volatile("s_waitcnt vmcnt(0)" ::: "memory");
    __syncthreads();
    if (threadIdx.x == 0) {
        unsigned* bar = b.bar;
        __builtin_amdgcn_s_waitcnt(0);
        unsigned nloc = b.st[0], nx = b.st[1];
        if (nloc == 0u) { xcd_barrier_complete(bar, b.x, nloc, nx); b.st[0] = nloc; b.st[1] = nx; }
        const unsigned old = xb_add(&bar[XB_XSUB(b.x)], 1u);
        const unsigned gen = old / nloc;
        if (old + 1u == (gen + 1u) * nloc) {
            __builtin_amdgcn_fence(__ATOMIC_RELEASE, "agent");
            asm volatile("s_waitcnt vmcnt(0)" ::: "memory");
            const unsigned og = xb_add(&bar[XB_TOP], 1u);
            const unsigned tg = og / nx;
            if (og + 1u == (tg + 1u) * nx) xb_add(&bar[XB_TOPGEN], 1u);
            else XB_SPIN(xb_ld(&bar[XB_TOPGEN]) == tg, bar);
            __builtin_amdgcn_fence(__ATOMIC_ACQUIRE, "agent");
            xb_add(&bar[XB_XGEN(b.x)], 1u);
            asm volatile("s_waitcnt vmcnt(0)" ::: "memory");
        } else {
            XB_SPIN(xb_ld(&bar[XB_XGEN(b.x)]) == gen, bar);
            __builtin_amdgcn_fence(__ATOMIC_ACQUIRE, "agent");
            asm volatile("s_waitcnt vmcnt(0)" ::: "memory");
        }
    }
    __syncthreads();
}


constexpr int NPH = 15;
constexpr unsigned GEMM_MASK = (1u << 1) | (1u << 2) | (1u << 3) | (1u << 5) | (1u << 9) | (1u << 10) | (1u << 11) | (1u << 12) | (1u << 13), ALL_MASK = 0x7FFFu;
constexpr unsigned MK_SW = (1u << 1) | (1u << 11), MK_RES = (1u << 2) | (1u << 9) | (1u << 12);
constexpr int LDS_BYTES = 147456;
struct Params { const float* in[26]; float* out; unsigned char* ws; int nprog, pad; unsigned char prog[32]; };

__device__ __forceinline__ void transpose_item(const float* W, int K, int N, const float* gain, bf16_t* WT, int blk, int mul, int add, LAS float* scr, int item, int lane) {
    const int nblk = N / 32, kb = item / nblk, nb = item % nblk, k0 = 64 * kb, n0 = 32 * nb;
    const int drow = (n0 / blk) * mul + add + (n0 % blk);
    float wv[32];
#pragma unroll
    for (int i = 0; i < 32; ++i) wv[i] = W[(size_t)(k0 + 2 * i + (lane >> 5)) * N + n0 + (lane & 31)];
    if (gain) {
#pragma unroll
        for (int i = 0; i < 32; ++i) wv[i] *= gain[k0 + 2 * i + (lane >> 5)];
    }
#pragma unroll
    for (int i = 0; i < 32; ++i) scr[(2 * i + (lane >> 5)) * 33 + (lane & 31)] = wv[i];
    asm volatile("s_waitcnt lgkmcnt(0)" ::: "memory");
    const int c = lane & 7;
#pragma unroll
    for (int j = 0; j < 4; ++j) { const int n = (lane >> 3) + 8 * j; const LAS float* s = scr + (8 * c) * 33 + n;
        u32x4 o; o.x = cvt_pk_bf16(s[0 * 33], s[1 * 33]); o.y = cvt_pk_bf16(s[2 * 33], s[3 * 33]); o.z = cvt_pk_bf16(s[4 * 33], s[5 * 33]); o.w = cvt_pk_bf16(s[6 * 33], s[7 * 33]);
        *(u32x4*)(WT + (size_t)(drow + n) * K + k0 + 8 * c) = o; }
    asm volatile("s_waitcnt lgkmcnt(0)" ::: "memory");
}

template <unsigned MASK> __global__ void __launch_bounds__(512, 2) mega(Params P) {
#define HAS(k) ((MASK >> (k)) & 1u)
    extern __shared__ __attribute__((aligned(16))) unsigned char lds_raw[];
    LAS unsigned char* lds = (LAS unsigned char*)lds_raw;
    cg::grid_group grid = cg::this_grid();
    const int G = gridDim.x, bx = blockIdx.x;
    const int wave0 = __builtin_amdgcn_readfirstlane((int)threadIdx.x >> 6);
    const int vcu = (G % 8 == 0) ? (bx % 8) * (G / 8) + bx / 8 : bx;
    typedef __attribute__((address_space(4))) const Params CParams;
    CParams* const pk = (CParams*)__builtin_amdgcn_kernarg_segment_ptr();
#define SS ((float*)(ws + WS_SS))
#define ROPE ((float*)(ws + WS_ROPE))
#define AGGA ((float*)(ws + WS_AGGA))
#define AGGH ((float*)(ws + WS_AGGH))
#define XB ((bf16_t*)(ws + WS_XB))
#define X ((float*)(ws + WS_X))
#define H ((bf16_t*)(ws + WS_H))
#define RA ((bf16_t*)(ws + WS_RA))
#define BXb ((bf16_t*)(ws + WS_BX))
#define QKV ((bf16_t*)(ws + WS_QKV))
#define PB ((bf16_t*)(ws + WS_PB))
#define U ((bf16_t*)(dob + DO_U))
#define UC ((bf16_t*)(dob + DO_UC))
#define GY ((bf16_t*)(dob + DO_GY))
#define MIX ((bf16_t*)(dob + DO_MIX))
#define PP ((bf16_t*)(dob + DO_PP))

    volatile LAS unsigned* bst = (volatile LAS unsigned*)(lds + 131072 + 512);
    if (threadIdx.x < 2) bst[threadIdx.x] = 0u;
    __syncthreads();
    const XcdBarrier xbar = xcd_barrier_post((unsigned*)(P.ws + WS_BAR), bst);
    const int nprog = P.nprog;
    for (int pi = 0; pi < nprog; ++pi) {
        CParams* pp = pk; asm volatile("" : "+s"(pp));
        unsigned char* const ws = pp->ws; unsigned char* const dob = (unsigned char*)pp->out;
        const int ph = pp->prog[pi];
        int wv_ = wave0; asm volatile("" : "+s"(wv_));
        int tid = wv_ * 64 + (int)__builtin_amdgcn_mbcnt_hi(~0u, __builtin_amdgcn_mbcnt_lo(~0u, 0u)); asm volatile("" : "+v"(tid));
#define THREAD_IDS() const int lane = tid & 63, wave = __builtin_amdgcn_readfirstlane(tid >> 6); const long gt = (long)vcu * 512 + tid, NT_ = (long)G * 512; const int gw = vcu * 8 + wave, NGW = G * 8; (void)lane; (void)gt; (void)NT_; (void)gw; (void)NGW
        if (HAS(0) && ph == 0) {
            THREAD_IDS();
            for (long i = gt; i < 4L * T; i += NT_) SS[i] = 0.f;
            for (long i = gt; i < 320 * 32; i += NT_) {
                const int pos = (int)(i >> 5), j = (int)(i & 31);
                const float inv = exp2f(-(float)j * 0.41524101186092029f);
                const float ang = (float)(pos < 256 ? pos : pos - 256) * inv;
                double rev = (double)ang * 0.15915494309189535; rev -= floor(rev);
                const float fr = (float)rev;
                ROPE[i] = __builtin_amdgcn_cosf(fr); ROPE[320 * 32 + i] = __builtin_amdgcn_sinf(fr);
            }
            for (long i = gt; i < 2 * LRUW; i += NT_) { const float nl = -pp->in[16][i]; ((float*)(ws + WS_C8))[i] = -8.0f * (fmaxf(nl, 0.f) + log1pf(__expf(-fabsf(nl)))) * 1.4426950408889634f; }
            { const float* p = pp->in[1];
              for (long i = gt; i < (long)T * PLED / 8; i += NT_) { const f32x4 a = *(const f32x4*)(p + i * 8), b = *(const f32x4*)(p + i * 8 + 4);
                  u32x4 w; w.x = cvt_pk_bf16(a[0], a[1]); w.y = cvt_pk_bf16(a[2], a[3]); w.z = cvt_pk_bf16(b[0], b[1]); w.w = cvt_pk_bf16(b[2], b[3]); *(u32x4*)(PB + i * 8) = w; } }
            { const float* x = pp->in[0]; const float* g1 = pp->in[2];
              for (int m = gw; m < T; m += NGW) {
                  const f32x4* xr = (const f32x4*)(x + (size_t)m * DM) + lane;
                  f32x4 v[8]; float s = 0.f;
#pragma unroll
                  for (int j = 0; j < 8; ++j) { v[j] = xr[64 * j]; s += (v[j][0] * v[j][0] + v[j][1] * v[j][1]) + (v[j][2] * v[j][2] + v[j][3] * v[j][3]); }
                  const float rs = __builtin_amdgcn_rsqf(wave_sum(s) * (1.0f / DM) + EPS);
                  u32x2* o8 = (u32x2*)(XB + (size_t)m * DM) + lane;
#pragma unroll
                  for (int j = 0; j < 8; ++j) { const f32x4 gg = *((const f32x4*)g1 + lane + 64 * j); u32x2 w; w.x = cvt_pk_bf16(v[j][0] * rs * gg[0], v[j][1] * rs * gg[1]); w.y = cvt_pk_bf16(v[j][2] * rs * gg[2], v[j][3] * rs * gg[3]); o8[64 * j] = w; }
              } }
            { LAS float* scr = (LAS float*)(lds + wave * 16384);
              constexpr int I_FF = (DM / 64) * (DFF / 32), I_IN = (DM / 64) * (INC / 32), I_SQ = (DM / 64) * (DM / 32), I_WP = (PLED / 64) * (DM / 32), I_L = 32 * 8;
              constexpr int NITEMS = 6 * I_FF + I_IN + 2 * I_SQ + I_WP + I_L;
              for (int it = gw; it < NITEMS; it += NGW) {
                  int r = it;
                  if (r < I_FF) { transpose_item(pp->in[3], DM, DFF, nullptr, (bf16_t*)(ws + WS_W13_1), 128, 256, 0, scr, r, lane); continue; } r -= I_FF;
                  if (r < I_FF) { transpose_item(pp->in[4], DM, DFF, nullptr, (bf16_t*)(ws + WS_W13_1), 128, 256, 128, scr, r, lane); continue; } r -= I_FF;
                  if (r < I_FF) { transpose_item(pp->in[5], DFF, DM, nullptr, (bf16_t*)(ws + WS_W2_1), DM, 0, 0, scr, r, lane); continue; } r -= I_FF;
                  if (r < I_FF) { transpose_item(pp->in[19], DM, DFF, pp->in[18], (bf16_t*)(ws + WS_W13_2), 128, 256, 0, scr, r, lane); continue; } r -= I_FF;
                  if (r < I_FF) { transpose_item(pp->in[20], DM, DFF, pp->in[18], (bf16_t*)(ws + WS_W13_2), 128, 256, 128, scr, r, lane); continue; } r -= I_FF;
                  if (r < I_FF) { transpose_item(pp->in[21], DFF, DM, nullptr, (bf16_t*)(ws + WS_W2_2), DM, 0, 0, scr, r, lane); continue; } r -= I_FF;
                  if (r < I_IN) { transpose_item(pp->in[7], DM, INC, pp->in[6], (bf16_t*)(ws + WS_WIN), INC, 0, 0, scr, r, lane); continue; } r -= I_IN;
                  if (r < I_SQ) { transpose_item(pp->in[17], DM, DM, nullptr, (bf16_t*)(ws + WS_WOUT), DM, 0, 0, scr, r, lane); continue; } r -= I_SQ;
                  if (r < I_SQ) { transpose_item(pp->in[23], DM, DM, pp->in[22], (bf16_t*)(ws + WS_WG), DM, 0, 0, scr, r, lane); continue; } r -= I_SQ;
                  if (r < I_WP) { transpose_item(pp->in[24], PLED, DM, nullptr, (bf16_t*)(ws + WS_WP), DM, 0, 0, scr, r, lane); continue; } r -= I_WP;
                  { const int mat = r >> 3, which = mat >> 4, dh = mat & 15;
                    transpose_item((which ? pp->in[14] : pp->in[12]) + (size_t)dh * 128 * 128, 128, 128, nullptr, (bf16_t*)(ws + WS_WL), 128, 0, dh * 256 + which * 128, scr, r & 7, lane); }
              } }
            __syncthreads();
        } else if (HAS(4) && ph == 4) {
            THREAD_IDS();
            { const float* qn = pp->in[8]; const float* kn = pp->in[9];
#define QK_LOAD(I_) (((I_) < (long)T * 160) ? *(const u32x4*)(QKV + (size_t)(((I_) >> 4) / 10) * QKVW + (int)(((I_) >> 4) % 10) * 128 + (int)((I_) & 15) * 8) : (u32x4){0u, 0u, 0u, 0u})
#define QK_TASK(W_, I_) do { const long i = (I_); if (i < (long)T * 160) { \
                  const int sub = (int)(i & 15); const long th = i >> 4; const int hh = (int)(th % 10); const int t = (int)(th / 10); \
                  const u32x4 w = (W_); \
                  const float v0 = bf_lo(w.x), v1 = bf_hi(w.x), v2 = bf_lo(w.y), v3 = bf_hi(w.y), v4 = bf_lo(w.z), v5 = bf_hi(w.z), v6 = bf_lo(w.w), v7 = bf_hi(w.w); \
                  float s = (v0 * v0 + v1 * v1) + (v2 * v2 + v3 * v3) + (v4 * v4 + v5 * v5) + (v6 * v6 + v7 * v7); \
                  s += __shfl_xor(s, 1); s += __shfl_xor(s, 2); s += __shfl_xor(s, 4); s += __shfl_xor(s, 8); \
                  float rs = __builtin_amdgcn_rsqf(s * (1.0f / 128.0f) + EPS); if (hh < 8) rs *= 0.12751743074602467f;   \
                  const float* gn = (hh < 8 ? qn : kn) + sub * 8; \
                  const int sp = t & (SEQ - 1); const int pos = (sub < 8) ? (sp >> 6) : 256 + (sp & 63); \
                  const float* ct = ROPE + pos * 32 + (sub & 7) * 4; const float* st = ct + 320 * 32; \
                  const f32x4 g0 = *(const f32x4*)gn, g1 = *(const f32x4*)(gn + 4), cc = *(const f32x4*)ct, ss = *(const f32x4*)st; \
                  const float a0 = v0 * rs * g0[0], b0 = v1 * rs * g0[1], a1 = v2 * rs * g0[2], b1 = v3 * rs * g0[3], a2 = v4 * rs * g1[0], b2 = v5 * rs * g1[1], a3 = v6 * rs * g1[2], b3 = v7 * rs * g1[3]; \
                  int w0 = 0, w1 = 0; \
                  w0 = __builtin_amdgcn_cvt_pk_fp8_f32(a0 * cc[0] - b0 * ss[0], a0 * ss[0] + b0 * cc[0], w0, false); w0 = __builtin_amdgcn_cvt_pk_fp8_f32(a1 * cc[1] - b1 * ss[1], a1 * ss[1] + b1 * cc[1], w0, true); \
                  w1 = __builtin_amdgcn_cvt_pk_fp8_f32(a2 * cc[2] - b2 * ss[2], a2 * ss[2] + b2 * cc[2], w1, false); w1 = __builtin_amdgcn_cvt_pk_fp8_f32(a3 * cc[3] - b3 * ss[3], a3 * ss[3] + b3 * cc[3], w1, true); \
                  unsigned char* dst8 = (hh < 8) ? (dob + DO_Q8 + (size_t)t * 1024 + hh * 128 + sub * 8) : (dob + DO_K8 + (size_t)t * 256 + (hh - 8) * 128 + sub * 8); \
                  *(u32x2*)dst8 = (u32x2){(unsigned)w0, (unsigned)w1}; } } while (0)
              for (long i0_ = gt; i0_ < (long)T * 160; i0_ += 4 * NT_) {
                  const u32x4 wq0 = QK_LOAD(i0_), wq1 = QK_LOAD(i0_ + NT_), wq2 = QK_LOAD(i0_ + 2 * NT_), wq3 = QK_LOAD(i0_ + 3 * NT_);
                  QK_TASK(wq0, i0_); QK_TASK(wq1, i0_ + NT_); QK_TASK(wq2, i0_ + 2 * NT_); QK_TASK(wq3, i0_ + 3 * NT_);
              } }
#undef QK_LOAD
#undef QK_TASK
            for (long i = gt; i < 262144; i += NT_) {
                const int n = (int)(i & 127), h = (int)((i >> 7) & 1), kvh = (int)((i >> 8) & 1), tile = (int)(i >> 9);
                const bf16_t* src = QKV + (size_t)tile * 64 * QKVW + 1280 + kvh * 128 + n;
                int wv8[8];
#pragma unroll
                for (int w = 0; w < 8; ++w) { float f[4];
#pragma unroll
                    for (int e = 0; e < 4; ++e) { const int sI = 4 * w + e; const int key = ((sI & 3) + 8 * ((sI & 15) >> 2) + 4 * h) + 32 * (sI >> 4); f[e] = __uint_as_float((unsigned)src[(size_t)key * QKVW] << 16); }
                    int x = 0; x = __builtin_amdgcn_cvt_pk_fp8_f32(f[0], f[1], x, false); x = __builtin_amdgcn_cvt_pk_fp8_f32(f[2], f[3], x, true); wv8[w] = x; }
                unsigned char* dv = dob + DO_V8 + ((size_t)((tile >> 8) * 2 + kvh) * 256 + (tile & 255)) * 8192 + n * 64 + h * 32;
                *(u32x4*)dv = (u32x4){(unsigned)wv8[0], (unsigned)wv8[1], (unsigned)wv8[2], (unsigned)wv8[3]};
                *(u32x4*)(dv + 16) = (u32x4){(unsigned)wv8[4], (unsigned)wv8[5], (unsigned)wv8[6], (unsigned)wv8[7]};
            }
            { const float* cw = pp->in[10]; const float* cb = pp->in[11];
#define CV_LOAD(I_, J_) ((((I_) < (long)T * 128) && ((int)(((I_) >> 7) & (SEQ - 1)) - 2 + (J_) >= 0) && ((int)(((I_) >> 7) & (SEQ - 1)) - 2 + (J_) < SEQ)) ? *(const u32x4*)(U + (size_t)((int)((I_) >> 7) - 2 + (J_)) * LRUW + (int)((I_) & 127) * 8) : (u32x4){0u, 0u, 0u, 0u})
#define CV_TAP(W_, J_) do { const u32x4 w = (W_); const f32x4 c0 = *(const f32x4*)(cw + (J_) * LRUW + c8), c1 = *(const f32x4*)(cw + (J_) * LRUW + c8 + 4); \
                  o0[0] += bf_lo(w.x) * c0[0]; o0[1] += bf_hi(w.x) * c0[1]; o0[2] += bf_lo(w.y) * c0[2]; o0[3] += bf_hi(w.y) * c0[3]; o1[0] += bf_lo(w.z) * c1[0]; o1[1] += bf_hi(w.z) * c1[1]; o1[2] += bf_lo(w.w) * c1[2]; o1[3] += bf_hi(w.w) * c1[3]; } while (0)
#define CV_TASK(I_, W0_, W1_, W2_, W3_) do { const long i = (I_); if (i < (long)T * 128) { const int c8 = (int)(i & 127) * 8; const int t = (int)(i >> 7); \
                  f32x4 o0 = *(const f32x4*)(cb + c8), o1 = *(const f32x4*)(cb + c8 + 4); \
                  CV_TAP(W0_, 0); CV_TAP(W1_, 1); CV_TAP(W2_, 2); CV_TAP(W3_, 3); \
                  u32x4 ow; ow.x = cvt_pk_bf16(o0[0], o0[1]); ow.y = cvt_pk_bf16(o0[2], o0[3]); ow.z = cvt_pk_bf16(o1[0], o1[1]); ow.w = cvt_pk_bf16(o1[2], o1[3]); \
                  *(u32x4*)(UC + (size_t)t * LRUW + c8) = ow; } } while (0)
              for (long i0_ = gt; i0_ < (long)T * 128; i0_ += 2 * NT_) {
                  const long i1_ = i0_ + NT_;
                  const u32x4 a0 = CV_LOAD(i0_, 0), a1 = CV_LOAD(i0_, 1), a2 = CV_LOAD(i0_, 2), a3 = CV_LOAD(i0_, 3), b0 = CV_LOAD(i1_, 0), b1 = CV_LOAD(i1_, 1), b2 = CV_LOAD(i1_, 2), b3 = CV_LOAD(i1_, 3);
                  CV_TASK(i0_, a0, a1, a2, a3); CV_TASK(i1_, b0, b1, b2, b3);
              } }
#undef CV_LOAD
#undef CV_TAP
#undef CV_TASK
        } else if (HAS(6) && ph == 6) {
            THREAD_IDS();
            const float* lam = (const float*)(ws + WS_C8);
            for (long i = gt; i < 2L * 2 * NCH * 512; i += NT_) {
                const int cp = (int)(i & 511); const int chunk = (int)((i >> 9) & (NCH - 1)); const int dir = (int)((i >> 16) & 1); const int b = (int)(i >> 17);
                const float k0 = lam[dir * LRUW + 2 * cp], k1 = lam[dir * LRUW + 2 * cp + 1];
                float A0 = 1.f, A1 = 1.f, H0 = 0.f, H1 = 0.f;
                const size_t base = ((size_t)dir * T + (size_t)b * SEQ + (size_t)chunk * CL) * LRUW + 2 * cp;
#pragma unroll 8
                for (int k = 0; k < CL; ++k) { const int tt = dir ? (CL - 1 - k) : k;
                    const unsigned rw = *(const unsigned*)(RA + base + (size_t)tt * LRUW), bw = *(const unsigned*)(BXb + base + (size_t)tt * LRUW);
                    const float a0 = __builtin_amdgcn_exp2f(k0 * bf_lo(rw)), a1 = __builtin_amdgcn_exp2f(k1 * bf_hi(rw));
                    H0 = a0 * H0 + bf_lo(bw); H1 = a1 * H1 + bf_hi(bw); A0 *= a0; A1 *= a1; }
                const size_t ao = (((size_t)b * 2 + dir) * NCH + chunk) * LRUW + 2 * cp;
                *(f32x2*)(AGGA + ao) = (f32x2){A0, A1}; *(f32x2*)(AGGH + ao) = (f32x2){H0, H1};
            }
        } else if (HAS(7) && ph == 7) {
            int seq_ = SEQ; asm volatile("" : "+s"(seq_));
            for (int u = vcu; u < 1024; u += G) {
                const int bkv = u >> 8, rem = u & 255, b = bkv >> 1, kvh = bkv & 1, gq = rem & 3, qb = rem >> 2, h = kvh * 4 + gq;
                const size_t rowb = (size_t)b * SEQ;
                att::attn_fp8_body(dob + DO_Q8 + (rowb + (size_t)qb * 256) * 1024 + h * 128, dob + DO_K8 + rowb * 256 + kvh * 128, dob + DO_V8 + (size_t)(b * 2 + kvh) * 256 * 8192,
                                   MIX + (rowb + (size_t)qb * 256) * DM + h * 128, seq_, (char*)lds_raw, tid);
            }
        } else if (HAS(8) && ph == 8) {
            THREAD_IDS();
            const float* lam = (const float*)(ws + WS_C8);
            for (long i = gt; i < 2L * NCH * 512; i += NT_) {
                const int cp = (int)(i & 511); const int chunk = (int)((i >> 9) & (NCH - 1)); const int b = (int)(i >> 16);
                float kf0, kf1, kb0, kb1;
                kf0 = lam[2 * cp]; kf1 = lam[2 * cp + 1]; kb0 = lam[LRUW + 2 * cp]; kb1 = lam[LRUW + 2 * cp + 1];
                float hf0 = 0.f, hf1 = 0.f, hb0 = 0.f, hb1 = 0.f;
#pragma unroll 8
                for (int j = 0; j < chunk; ++j) { const size_t ao = (((size_t)b * 2 + 0) * NCH + j) * LRUW + 2 * cp; const f32x2 a = *(const f32x2*)(AGGA + ao), hh = *(const f32x2*)(AGGH + ao); hf0 = a[0] * hf0 + hh[0]; hf1 = a[1] * hf1 + hh[1]; }
#pragma unroll 8
                for (int j = NCH - 1; j > chunk; --j) { const size_t ao = (((size_t)b * 2 + 1) * NCH + j) * LRUW + 2 * cp; const f32x2 a = *(const f32x2*)(AGGA + ao), hh = *(const f32x2*)(AGGH + ao); hb0 = a[0] * hb0 + hh[0]; hb1 = a[1] * hb1 + hh[1]; }
                const size_t row0 = (size_t)b * SEQ + (size_t)chunk * CL;
                const size_t fbase = row0 * LRUW + 2 * cp, bbase = ((size_t)T + row0) * LRUW + 2 * cp;
                bf16_t* mx = MIX + row0 * DM + 1024 + 2 * cp;
                {
                    unsigned rwc[8], bwc[8], rwn[8], bwn[8];
#pragma unroll
                    for (int u = 0; u < 8; ++u) { rwc[u] = *(const unsigned*)(RA + fbase + (size_t)u * LRUW); bwc[u] = *(const unsigned*)(BXb + fbase + (size_t)u * LRUW); }
                    for (int k0 = 0; k0 < CL; k0 += 8) {
                        const int kn = (k0 + 8 < CL) ? k0 + 8 : k0;
#pragma unroll
                        for (int u = 0; u < 8; ++u) { rwn[u] = *(const unsigned*)(RA + fbase + (size_t)(kn + u) * LRUW); bwn[u] = *(const unsigned*)(BXb + fbase + (size_t)(kn + u) * LRUW); }
#pragma unroll
                        for (int u = 0; u < 8; ++u) {
                            hf0 = __builtin_amdgcn_exp2f(kf0 * bf_lo(rwc[u])) * hf0 + bf_lo(bwc[u]); hf1 = __builtin_amdgcn_exp2f(kf1 * bf_hi(rwc[u])) * hf1 + bf_hi(bwc[u]);
                            *(unsigned*)(mx + (size_t)(k0 + u) * DM) = cvt_pk_bf16(hf0, hf1); }
#pragma unroll
                        for (int u = 0; u < 8; ++u) { rwc[u] = rwn[u]; bwc[u] = bwn[u]; }
                    }
                }
                asm volatile("s_waitcnt vmcnt(0)" ::: "memory");
                {
                    unsigned rwc[8], bwc[8], fwc[8], gwc[8], rwn[8], bwn[8], fwn[8], gwn[8];
#pragma unroll
                    for (int u = 0; u < 8; ++u) { const int k = CL - 1 - u; rwc[u] = *(const unsigned*)(RA + bbase + (size_t)k * LRUW); bwc[u] = *(const unsigned*)(BXb + bbase + (size_t)k * LRUW);
                        fwc[u] = *(const unsigned*)(mx + (size_t)k * DM); gwc[u] = *(const unsigned*)(GY + (row0 + k) * LRUW + 2 * cp); }
                    for (int k0 = CL - 1; k0 >= 0; k0 -= 8) {
                        const int kn = (k0 - 8 >= 0) ? k0 - 8 : k0;
#pragma unroll
                        for (int u = 0; u < 8; ++u) { const int k = kn - u; rwn[u] = *(const unsigned*)(RA + bbase + (size_t)k * LRUW); bwn[u] = *(const unsigned*)(BXb + bbase + (size_t)k * LRUW);
                            fwn[u] = *(const unsigned*)(mx + (size_t)k * DM); gwn[u] = *(const unsigned*)(GY + (row0 + k) * LRUW + 2 * cp); }
#pragma unroll
                        for (int u = 0; u < 8; ++u) { const int k = k0 - u;
                            hb0 = __builtin_amdgcn_exp2f(kb0 * bf_lo(rwc[u])) * hb0 + bf_lo(bwc[u]); hb1 = __builtin_amdgcn_exp2f(kb1 * bf_hi(rwc[u])) * hb1 + bf_hi(bwc[u]);
                            *(unsigned*)(mx + (size_t)k * DM) = cvt_pk_bf16((bf_lo(fwc[u]) + hb0) * bf_lo(gwc[u]), (bf_hi(fwc[u]) + hb1) * bf_hi(gwc[u])); }
#pragma unroll
                        for (int u = 0; u < 8; ++u) { rwc[u] = rwn[u]; bwc[u] = bwn[u]; fwc[u] = fwn[u]; gwc[u] = gwn[u]; }
                    }
                }
            }
        } else if (HAS(14) && ph == 14) {
            THREAD_IDS();
            const float* gf = pp->in[25]; const float* ss4 = SS + 3 * T;
            for (int m = gw; m < T; m += NGW) {
                const float rs = __builtin_amdgcn_rsqf(ss4[m] * (1.0f / DM) + EPS);
                const f32x4* xr = (const f32x4*)(X + (size_t)m * DM) + lane; f32x4* orow = (f32x4*)(pp->out + (size_t)m * DM) + lane;
#pragma unroll
                for (int j = 0; j < 8; ++j) { const f32x4 gg = *((const f32x4*)gf + lane + 64 * j); orow[64 * j] = xr[64 * j] * rs * gg; }
            }
        } else if (MASK & GEMM_MASK) {
            pg8::Gemm g; g.M = T; g.amask = 0; g.astride = 0;
            pg8::StaticOrder S;
#define EPI_INIT(E) do { E.alpha = 1.f; E.base = nullptr; E.Xo = nullptr; E.XBo = nullptr; E.ss_out = nullptr; E.ss_in = nullptr; E.O0 = nullptr; E.O1 = nullptr; E.O2 = nullptr; E.aux = nullptr; E.ba = nullptr; E.bi = nullptr; E.lam = nullptr; } while (0)
            if ((HAS(1) || HAS(11)) && (ph == 1 || ph == 11)) {
                pg8::Epi<pg8::M_SWIGLU> E; EPI_INIT(E);
                g.A = XB; g.Bt = (bf16_t*)(ws + (ph == 1 ? WS_W13_1 : WS_W13_2)); g.N = 2 * DFF; g.K = DM; g.lda = DM; g.ldb = DM; E.O0 = H; E.ss_in = (ph == 1) ? nullptr : SS + T;
                S.init(g.M, g.N, G, bx); pg8::gemm_phase(lds, g, S, E, tid);
            } else if ((HAS(2) || HAS(9) || HAS(12)) && (ph == 2 || ph == 9 || ph == 12)) {
                pg8::Epi<pg8::M_RESID> E; EPI_INIT(E); E.Xo = X; E.XBo = XB;
                if (ph == 2) { g.A = H; g.Bt = (bf16_t*)(ws + WS_W2_1); g.K = DFF; g.lda = DFF; g.ldb = DFF; E.base = pp->in[0]; E.alpha = 0.5f; E.ss_out = SS; }
                else if (ph == 9) { g.A = MIX; g.Bt = (bf16_t*)(ws + WS_WOUT); g.K = DM; g.lda = DM; g.ldb = DM; E.base = X; E.alpha = 1.f; E.ss_out = SS + T; }
                else { g.A = H; g.Bt = (bf16_t*)(ws + WS_W2_2); g.K = DFF; g.lda = DFF; g.ldb = DFF; E.base = X; E.alpha = 0.5f; E.ss_out = SS + 2 * T; }
                g.N = DM;
                S.init(g.M, g.N, G, bx); pg8::gemm_phase(lds, g, S, E, tid);
            } else if (HAS(3) && ph == 3) {
                pg8::Epi<pg8::M_WIN> E; EPI_INIT(E);
                g.A = XB; g.Bt = (bf16_t*)(ws + WS_WIN); g.N = INC; g.K = DM; g.lda = DM; g.ldb = DM; E.ss_in = SS; E.O0 = QKV; E.O1 = U; E.O2 = GY;
                S.init(g.M, g.N, G, bx); pg8::gemm_phase(lds, g, S, E, tid);
            } else if (HAS(5) && ph == 5) {
                pg8::Epi<pg8::M_GATES> E; EPI_INIT(E);
                g.A = UC; g.Bt = (bf16_t*)(ws + WS_WL); g.N = 4096; g.K = 128; g.lda = LRUW; g.ldb = 128; g.amask = 7; g.astride = 256; E.O0 = RA; E.O1 = BXb; E.aux = UC;
                E.ba = pp->in[13]; E.bi = pp->in[15]; E.lam = (const float*)(ws + WS_C8);
                S.init(g.M, g.N, G, bx); pg8::gemm_phase(lds, g, S, E, tid);
            } else if (HAS(10) && ph == 10) {
                pg8::Epi<pg8::M_PLAIN> E; EPI_INIT(E);
                g.A = PB; g.Bt = (bf16_t*)(ws + WS_WP); g.N = DM; g.K = PLED; g.lda = PLED; g.ldb = PLED; E.O0 = PP;
                S.init(g.M, g.N, G, bx); pg8::gemm_phase(lds, g, S, E, tid);
            } else if (HAS(13)) {
                pg8::Epi<pg8::M_PLE> E; EPI_INIT(E);
                g.A = XB; g.Bt = (bf16_t*)(ws + WS_WG); g.N = DM; g.K = DM; g.lda = DM; g.ldb = DM; E.Xo = X; E.base = X; E.ss_in = SS + 2 * T; E.ss_out = SS + 3 * T; E.aux = PP;
                S.init(g.M, g.N, G, bx); pg8::gemm_phase(lds, g, S, E, tid);
            }
#undef EPI_INIT
        }
        if (pi + 1 < nprog && ph != 7 && ph != 9) { if (pi == 0) grid.sync(); else xcd_barrier(xbar); }
    }
}

#if MK_ONE_LAUNCH
#define MEGA_MAIN mega<ALL_MASK>
#else
#define MEGA_MAIN mega<MK_SW>
#endif
extern "C" void kernel_launch(void* const* d_in, const int* in_sizes, int n_in, void* d_out, int out_size, void* d_ws, size_t ws_size, hipStream_t stream) {
    static int grid = 0;
    if (grid == 0) {
        if (n_in != 26 || in_sizes[0] != T * DM || out_size != T * DM || ws_size < WS_END) { fprintf(stderr, "kernel_launch: shape/workspace mismatch (n_in %d, ws %zu)\n", n_in, ws_size); grid = -1; return; }
        int dev = 0, cus = 0, per_cu = 0;
        (void)hipGetDevice(&dev); (void)hipDeviceGetAttribute(&cus, hipDeviceAttributeMultiprocessorCount, dev);
        bool ok = hipFuncSetAttribute((const void*)MEGA_MAIN, hipFuncAttributeMaxDynamicSharedMemorySize, LDS_BYTES) == hipSuccess;
#if !MK_ONE_LAUNCH
        ok = ok && hipFuncSetAttribute((const void*)mega<1u << 0>, hipFuncAttributeMaxDynamicSharedMemorySize, LDS_BYTES) == hipSuccess;
        ok = ok && hipFuncSetAttribute((const void*)mega<1u << 4>, hipFuncAttributeMaxDynamicSharedMemorySize, LDS_BYTES) == hipSuccess;
        ok = ok && hipFuncSetAttribute((const void*)mega<1u << 6>, hipFuncAttributeMaxDynamicSharedMemorySize, LDS_BYTES) == hipSuccess;
        ok = ok && hipFuncSetAttribute((const void*)mega<1u << 7>, hipFuncAttributeMaxDynamicSharedMemorySize, LDS_BYTES) == hipSuccess;
        ok = ok && hipFuncSetAttribute((const void*)mega<1u << 8>, hipFuncAttributeMaxDynamicSharedMemorySize, LDS_BYTES) == hipSuccess;
        ok = ok && hipFuncSetAttribute((const void*)mega<1u << 14>, hipFuncAttributeMaxDynamicSharedMemorySize, LDS_BYTES) == hipSuccess;
        ok = ok && hipFuncSetAttribute((const void*)mega<MK_RES>, hipFuncAttributeMaxDynamicSharedMemorySize, LDS_BYTES) == hipSuccess;
        ok = ok && hipFuncSetAttribute((const void*)mega<1u << 3>, hipFuncAttributeMaxDynamicSharedMemorySize, LDS_BYTES) == hipSuccess;
        ok = ok && hipFuncSetAttribute((const void*)mega<1u << 5>, hipFuncAttributeMaxDynamicSharedMemorySize, LDS_BYTES) == hipSuccess;
        ok = ok && hipFuncSetAttribute((const void*)mega<1u << 10>, hipFuncAttributeMaxDynamicSharedMemorySize, LDS_BYTES) == hipSuccess;
        ok = ok && hipFuncSetAttribute((const void*)mega<1u << 13>, hipFuncAttributeMaxDynamicSharedMemorySize, LDS_BYTES) == hipSuccess;
#endif
        if (!ok) { fprintf(stderr, "kernel_launch: hipFuncSetAttribute failed\n"); grid = -1; return; }
        if (hipOccupancyMaxActiveBlocksPerMultiprocessor(&per_cu, (const void*)MEGA_MAIN, 512, LDS_BYTES) != hipSuccess || per_cu < 1) { fprintf(stderr, "kernel_launch: occupancy query gives %d\n", per_cu); per_cu = 1; }
        (void)hipGetLastError();
        grid = cus * per_cu;
    }
    if (grid < 0) return;
    Params p{};
    for (int i = 0; i < 26; ++i) p.in[i] = (const float*)d_in[i];
    p.out = (float*)d_out; p.ws = (unsigned char*)d_ws;
#if MK_ONE_LAUNCH
#ifdef MK_PROG
    { const unsigned char prog[] = {MK_PROG}; p.nprog = (int)sizeof(prog); for (int i = 0; i < p.nprog; ++i) p.prog[i] = prog[i]; }
#else
    p.nprog = NPH; for (int i = 0; i < NPH; ++i) p.prog[i] = (unsigned char)i;
#endif
    void* args[] = {&p};
    if (hipMemsetAsync((char*)d_ws + WS_BAR, 0, BAR_BYTES, stream) != hipSuccess) { fprintf(stderr, "kernel_launch: memset of barrier words failed\n"); return; }
    hipError_t e = hipLaunchCooperativeKernel((const void*)MEGA_MAIN, dim3(grid), dim3(512), args, LDS_BYTES, stream);
    if (e != hipSuccess) fprintf(stderr, "cooperative launch failed: %s (grid %d)\n", hipGetErrorString(e), grid);
#else
    for (int ph = 0; ph < NPH; ++ph) {
        p.nprog = 1; p.prog[0] = (unsigned char)ph;
        switch (ph) {
        case 0:  hipLaunchKernelGGL(mega<1u << 0>, dim3(grid), dim3(512), LDS_BYTES, stream, p); break;
        case 4:  hipLaunchKernelGGL(mega<1u << 4>, dim3(grid), dim3(512), LDS_BYTES, stream, p); break;
        case 6:  hipLaunchKernelGGL(mega<1u << 6>, dim3(grid), dim3(512), LDS_BYTES, stream, p); break;
        case 7:  hipLaunchKernelGGL(mega<1u << 7>, dim3(grid), dim3(512), LDS_BYTES, stream, p); break;
        case 8:  hipLaunchKernelGGL(mega<1u << 8>, dim3(grid), dim3(512), LDS_BYTES, stream, p); break;
        case 14: hipLaunchKernelGGL(mega<1u << 14>, dim3(grid), dim3(512), LDS_BYTES, stream, p); break;
        case 1: case 11: hipLaunchKernelGGL(mega<MK_SW>, dim3(grid), dim3(512), LDS_BYTES, stream, p); break;
        case 2: case 9: case 12: hipLaunchKernelGGL(mega<MK_RES>, dim3(grid), dim3(512), LDS_BYTES, stream, p); break;
        case 3:  hipLaunchKernelGGL(mega<1u << 3>, dim3(grid), dim3(512), LDS_BYTES, stream, p); break;
        case 5:  hipLaunchKernelGGL(mega<1u << 5>, dim3(grid), dim3(512), LDS_BYTES, stream, p); break;
        case 10: hipLaunchKernelGGL(mega<1u << 10>, dim3(grid), dim3(512), LDS_BYTES, stream, p); break;
        default: hipLaunchKernelGGL(mega<1u << 13>, dim3(grid), dim3(512), LDS_BYTES, stream, p); break;
        }
    }
#endif
}
```
